# Optimizing an MI355X kernel written in HIP

```python
import math
import jax, jax.numpy as jnp
from jax import lax
import numpy as np

D_MODEL = 2048
BATCH = 2
SEQ = 8192
DEPTH = 1
DEC_BATCH = 128
DEC_SEQ = 4
PAST_LEN = 16384
PAGE_SIZE = 128

D_MIX = D_MODEL
D_RNN = D_MIX // 2
D_ATTN = D_MIX - D_RNN
HEAD_DIM = 64
N_HEADS = D_ATTN // HEAD_DIM
KV_HEADS = 4
GQA_GROUP = N_HEADS // KV_HEADS
KV_DIM = KV_HEADS * HEAD_DIM
RNN_BLOCKS = 16
RNN_BLOCK = D_RNN // RNN_BLOCKS
CONV_W = 4
RG_C = 8.0
WINDOW = 128
BLOCK = WINDOW
CACHE_WIN = min(WINDOW, PAST_LEN)
N_BUCKETS = 32
MAX_EXACT = N_BUCKETS // 2
REL_MAX_DIST = 128
D_FF = 3 * D_MODEL
FFN_CONV_W = 3
EPS = 1e-6
NEG_INF = -1e30
ATTN_SCALE = HEAD_DIM ** -0.5
D_IN_PROJ = 2 * D_RNN + D_ATTN + 2 * KV_DIM
SPLIT_IDX = (D_RNN, 2 * D_RNN, 2 * D_RNN + D_ATTN, 2 * D_RNN + D_ATTN + KV_DIM)

kernel_name = "hymba_rglru_swa_sink_convffn_step"


def _rmsnorm(x, g):
    xf = x.astype(jnp.float32)
    y = xf * lax.rsqrt(jnp.mean(xf * xf, axis=-1, keepdims=True) + EPS)
    return (y * g.astype(jnp.float32)).astype(x.dtype)


def _causal_dwconv(x, buf, w, b):
    K = w.shape[0]
    T = x.shape[1]
    xp = jnp.concatenate([buf.astype(x.dtype), x], axis=1)
    y = b + sum(xp[:, k:k + T] * w[k] for k in range(K))
    return y, xp[:, xp.shape[1] - (K - 1):]


def _rglru(x, h0, w_a, b_a, w_x, b_x, lam):
    B, T, C = x.shape
    xb = x.reshape(B, T, RNN_BLOCKS, RNN_BLOCK)
    r = jax.nn.sigmoid((jnp.einsum("bthi,hij->bthj", xb, w_a).reshape(B, T, C) + b_a).astype(jnp.float32))
    i = jax.nn.sigmoid((jnp.einsum("bthi,hij->bthj", xb, w_x).reshape(B, T, C) + b_x).astype(jnp.float32))
    log_a = -RG_C * r * jax.nn.softplus(-lam.astype(jnp.float32))
    a = jnp.exp(log_a)
    u = jnp.sqrt(-jnp.expm1(2.0 * log_a)) * (i * x.astype(jnp.float32))

    def step(h, au):
        a_t, u_t = au
        h = a_t * h + u_t
        return h, h

    hT, hs = lax.scan(step, h0.astype(jnp.float32), (jnp.swapaxes(a, 0, 1), jnp.swapaxes(u, 0, 1)))
    return jnp.swapaxes(hs, 0, 1).astype(x.dtype), hT.astype(x.dtype)


def _t5_bucket(d):
    n = jnp.maximum(d, 0)
    nf = jnp.maximum(n, 1).astype(jnp.float32)
    large = MAX_EXACT + (jnp.log(nf / MAX_EXACT) / math.log(REL_MAX_DIST / MAX_EXACT)
                         * (N_BUCKETS - MAX_EXACT)).astype(jnp.int32)
    large = jnp.minimum(large, N_BUCKETS - 1)
    return jnp.where(n < MAX_EXACT, n, large)


def _rel_bias(dist, table):
    b = table[_t5_bucket(dist)].astype(jnp.float32)
    b = jnp.moveaxis(b, -1, 0)
    return b.reshape(KV_HEADS, GQA_GROUP, dist.shape[0], dist.shape[1])


def _attend(q, k, v, bias, valid, sinks):
    lead = q.shape[:-3]
    Tq = q.shape[-3]
    qg = q.reshape(*lead, Tq, KV_HEADS, GQA_GROUP, HEAD_DIM)
    s = jnp.einsum("...qkgd,...skd->...kgqs", qg, k).astype(jnp.float32) * ATTN_SCALE + bias
    s = jnp.where(valid, s, NEG_INF)
    sink = sinks.astype(jnp.float32).reshape(KV_HEADS, GQA_GROUP, 1, 1)
    m = jnp.maximum(jnp.max(s, axis=-1, keepdims=True), sink)
    p = jnp.exp(s - m)
    w = p / (jnp.sum(p, axis=-1, keepdims=True) + jnp.exp(sink - m))
    o = jnp.einsum("...kgqs,...skd->...qkgd", w.astype(v.dtype), v)
    return o.reshape(*lead, Tq, N_HEADS, HEAD_DIM)


def _swa_prompt(q, k, v, table, sinks):
    B, S = q.shape[0], q.shape[1]
    nb = S // BLOCK
    qb = q.reshape(B, nb, BLOCK, N_HEADS, HEAD_DIM)
    pad = jnp.zeros((B, BLOCK, KV_HEADS, HEAD_DIM), k.dtype)
    kprev = jnp.concatenate([pad, k[:, :S - BLOCK]], axis=1).reshape(B, nb, BLOCK, KV_HEADS, HEAD_DIM)
    vprev = jnp.concatenate([pad, v[:, :S - BLOCK]], axis=1).reshape(B, nb, BLOCK, KV_HEADS, HEAD_DIM)
    kband = jnp.concatenate([kprev, k.reshape(B, nb, BLOCK, KV_HEADS, HEAD_DIM)], axis=2)
    vband = jnp.concatenate([vprev, v.reshape(B, nb, BLOCK, KV_HEADS, HEAD_DIM)], axis=2)
    qi = jnp.arange(BLOCK)[:, None]
    kj = jnp.arange(2 * BLOCK)[None, :]
    dist = BLOCK + qi - kj
    k_abs = jnp.arange(nb)[:, None, None] * BLOCK - BLOCK + kj
    valid = (dist >= 0) & (dist < WINDOW) & (k_abs >= 0)
    valid = valid[:, None, None]
    out = _attend(qb, kband, vband, _rel_bias(dist, table), valid, sinks)
    return out.reshape(B, S, N_HEADS, HEAD_DIM), k[:, S - CACHE_WIN:], v[:, S - CACHE_WIN:]


def _swa_sample(q, k, v, k_buf, v_buf, table, sinks):
    T = q.shape[1]
    W = k_buf.shape[1]
    kk = jnp.concatenate([k_buf.astype(k.dtype), k], axis=1)
    vv = jnp.concatenate([v_buf.astype(v.dtype), v], axis=1)
    qi = jnp.arange(T)[:, None]
    kj = jnp.arange(W + T)[None, :]
    dist = W + qi - kj
    valid = (dist >= 0) & (dist < WINDOW)
    out = _attend(q, kk, vv, _rel_bias(dist, table), valid, sinks)
    return out, kk[:, kk.shape[1] - W:], vv[:, vv.shape[1] - W:]


def _layer(x, rnn_conv_buf, rnn_h0, k_buf, v_buf, ffn_buf, lw, rel_bias_table, prompt):
    B, T, _ = x.shape
    xn = _rmsnorm(x, lw["norm_mix_g"])
    proj = jnp.einsum("btd,de->bte", xn, lw["w_in"])
    x_rnn, g_rnn, q, k, v = jnp.split(proj, SPLIT_IDX, axis=-1)
    xc, new_rnn_conv = _causal_dwconv(x_rnn, rnn_conv_buf, lw["rnn_conv_w"], lw["rnn_conv_b"])
    h_rnn, new_h = _rglru(xc, rnn_h0, lw["w_gate_a"], lw["b_gate_a"], lw["w_gate_x"], lw["b_gate_x"], lw["rnn_lambda"])
    y_rnn = jax.nn.gelu(g_rnn) * h_rnn
    q = q.reshape(B, T, N_HEADS, HEAD_DIM)
    k = k.reshape(B, T, KV_HEADS, HEAD_DIM)
    v = v.reshape(B, T, KV_HEADS, HEAD_DIM)
    if prompt:
        y_attn, new_k, new_v = _swa_prompt(q, k, v, rel_bias_table, lw["attn_sinks"])
    else:
        y_attn, new_k, new_v = _swa_sample(q, k, v, k_buf, v_buf, rel_bias_table, lw["attn_sinks"])
    merged = jnp.concatenate([_rmsnorm(y_rnn, lw["gn_rnn_g"]),
                              _rmsnorm(y_attn.reshape(B, T, D_ATTN), lw["gn_attn_g"])], axis=-1)
    h = x + jnp.einsum("bte,ed->btd", merged, lw["w_out"])
    hn = _rmsnorm(h, lw["norm_ffn_g"])
    up = jnp.einsum("btd,df->btf", hn, lw["w_up"])
    upc, new_ffn = _causal_dwconv(up, ffn_buf, lw["ffn_conv_w"], lw["ffn_conv_b"])
    gate, val = jnp.split(upc, 2, axis=-1)
    out = h + jnp.einsum("btf,fd->btd", jax.nn.gelu(gate) * val, lw["w_down"])
    return out, (new_rnn_conv, new_h, new_k, new_v, new_ffn)


def setup_inputs(seed: int = 0) -> dict:
    key = jax.random.key(seed)
    ks = jax.random.split(key, 32)
    f = jnp.float32
    nrm = lambda k, shape, s: jax.random.normal(k, shape, f) * s
    a0 = jax.random.uniform(ks[14], (DEPTH, D_RNN), f, minval=0.9, maxval=0.999)
    return {
        "x_prompt": nrm(ks[0], (BATCH, SEQ, D_MODEL), 1.0),
        "x_sample": nrm(ks[1], (DEC_BATCH, DEC_SEQ, D_MODEL), 1.0),
        "state_rnn_conv": nrm(ks[2], (DEPTH, DEC_BATCH, CONV_W - 1, D_RNN), 1.0),
        "state_rnn_h": nrm(ks[3], (DEPTH, DEC_BATCH, D_RNN), 0.5),
        "cache_win_k": nrm(ks[4], (DEPTH, DEC_BATCH, CACHE_WIN, KV_HEADS, HEAD_DIM), 1.0),
        "cache_win_v": nrm(ks[5], (DEPTH, DEC_BATCH, CACHE_WIN, KV_HEADS, HEAD_DIM), 1.0),
        "state_ffn_conv": nrm(ks[6], (DEPTH, DEC_BATCH, FFN_CONV_W - 1, 2 * D_FF), 1.0),
        "norm_mix_g": 1.0 + nrm(ks[7], (DEPTH, D_MODEL), 0.02),
        "w_in": nrm(ks[8], (DEPTH, D_MODEL, D_IN_PROJ), D_MODEL ** -0.5),
        "rnn_conv_w": nrm(ks[9], (DEPTH, CONV_W, D_RNN), CONV_W ** -0.5),
        "rnn_conv_b": nrm(ks[10], (DEPTH, D_RNN), 0.02),
        "w_gate_a": nrm(ks[11], (DEPTH, RNN_BLOCKS, RNN_BLOCK, RNN_BLOCK), RNN_BLOCK ** -0.5),
        "b_gate_a": nrm(ks[12], (DEPTH, D_RNN), 0.02),
        "w_gate_x": nrm(ks[13], (DEPTH, RNN_BLOCKS, RNN_BLOCK, RNN_BLOCK), RNN_BLOCK ** -0.5),
        "b_gate_x": nrm(ks[15], (DEPTH, D_RNN), 0.02),
        "rnn_lambda": jnp.log(a0) - jnp.log1p(-a0),
        "attn_sinks": nrm(ks[16], (DEPTH, N_HEADS), 0.5),
        "rel_bias_table": nrm(ks[17], (N_BUCKETS, N_HEADS), 0.5),
        "gn_rnn_g": 1.0 + nrm(ks[18], (DEPTH, D_RNN), 0.02),
        "gn_attn_g": 1.0 + nrm(ks[19], (DEPTH, D_ATTN), 0.02),
        "w_out": nrm(ks[20], (DEPTH, D_MIX, D_MODEL), D_MIX ** -0.5),
        "norm_ffn_g": 1.0 + nrm(ks[21], (DEPTH, D_MODEL), 0.02),
        "w_up": nrm(ks[22], (DEPTH, D_MODEL, 2 * D_FF), D_MODEL ** -0.5),
        "ffn_conv_w": nrm(ks[23], (DEPTH, FFN_CONV_W, 2 * D_FF), FFN_CONV_W ** -0.5),
        "ffn_conv_b": nrm(ks[24], (DEPTH, 2 * D_FF), 0.02),
        "w_down": nrm(ks[25], (DEPTH, D_FF, D_MODEL), D_FF ** -0.5),
        "norm_final_g": 1.0 + nrm(ks[26], (D_MODEL,), 0.02),
    }


def reference(x_prompt, x_sample, state_rnn_conv, state_rnn_h, cache_win_k, cache_win_v, state_ffn_conv,
              norm_mix_g, w_in, rnn_conv_w, rnn_conv_b, w_gate_a, b_gate_a, w_gate_x, b_gate_x, rnn_lambda,
              attn_sinks, rel_bias_table, gn_rnn_g, gn_attn_g, w_out, norm_ffn_g, w_up, ffn_conv_w, ffn_conv_b,
              w_down, norm_final_g):
    xp, xs = x_prompt, x_sample
    Bp = x_prompt.shape[0]
    dt = x_prompt.dtype
    p_states, s_states = [], []
    for l in range(DEPTH):
        lw = {
            "norm_mix_g": norm_mix_g[l], "w_in": w_in[l], "rnn_conv_w": rnn_conv_w[l], "rnn_conv_b": rnn_conv_b[l],
            "w_gate_a": w_gate_a[l], "b_gate_a": b_gate_a[l], "w_gate_x": w_gate_x[l], "b_gate_x": b_gate_x[l],
            "rnn_lambda": rnn_lambda[l], "attn_sinks": attn_sinks[l], "gn_rnn_g": gn_rnn_g[l],
            "gn_attn_g": gn_attn_g[l], "w_out": w_out[l], "norm_ffn_g": norm_ffn_g[l], "w_up": w_up[l],
            "ffn_conv_w": ffn_conv_w[l], "ffn_conv_b": ffn_conv_b[l], "w_down": w_down[l],
        }
        xp, st_p = _layer(xp,
                          jnp.zeros((Bp, CONV_W - 1, D_RNN), dt),
                          jnp.zeros((Bp, D_RNN), dt),
                          None, None,
                          jnp.zeros((Bp, FFN_CONV_W - 1, 2 * D_FF), dt),
                          lw, rel_bias_table, True)
        xs, st_s = _layer(xs, state_rnn_conv[l], state_rnn_h[l], cache_win_k[l], cache_win_v[l],
                          state_ffn_conv[l], lw, rel_bias_table, False)
        p_states.append(st_p)
        s_states.append(st_s)
    y_prompt = _rmsnorm(xp, norm_final_g)
    y_sample = _rmsnorm(xs, norm_final_g)
    ps = [jnp.stack(z, axis=0) for z in zip(*p_states)]
    ss = [jnp.stack(z, axis=0) for z in zip(*s_states)]
    return (y_prompt, y_sample, ps[0], ps[1], ps[2], ps[3], ps[4], ss[0], ss[1], ss[2], ss[3], ss[4])
```

```cpp
#include <hip/hip_runtime.h>
#include <hip/hip_cooperative_groups.h>
#include <cstdint>
#include <cstdio>
namespace cg = cooperative_groups;

#ifndef MK_N_LAUNCHES
#define MK_N_LAUNCHES 1
#endif

#define LAS __attribute__((address_space(3)))
typedef unsigned short bf16_t;
typedef short bf16x8 __attribute__((ext_vector_type(8)));
typedef short s16x4 __attribute__((ext_vector_type(4)));
typedef float f32x4 __attribute__((ext_vector_type(4)));
typedef float f32x2 __attribute__((ext_vector_type(2)));
typedef unsigned u32x4 __attribute__((ext_vector_type(4)));
typedef unsigned u32x2 __attribute__((ext_vector_type(2)));
typedef __bf16 bf16x2_t __attribute__((ext_vector_type(2)));

constexpr int DM = 2048, SEQ = 8192, NB = 2, MP = NB * SEQ, NSEQ_S = 128, TS = 4, MS = NSEQ_S * TS, MT = MP + MS;
constexpr int DRNN = 1024, DATT = 1024, NPROJ = 3584, DFF = 6144, NUP = 12288, NHEAD = 16, KVH = 4, HD = 64;
constexpr int COL_XR = 0, COL_GR = 1024, COL_Q = 2048, COL_K = 3072, COL_V = 3328;
constexpr float EPS = 1e-6f;
constexpr int NTHREADS = 512, NWAVES = 8;
constexpr size_t O_Y = 0, O_P_RCONV = (size_t)MT * DM, O_P_RH = O_P_RCONV + 2 * 3 * 1024, O_P_WK = O_P_RH + 2 * 1024, O_P_WV = O_P_WK + 2 * 128 * 256,
                 O_P_FFN = O_P_WV + 2 * 128 * 256, O_S_RCONV = O_P_FFN + 2 * 2 * NUP, O_S_RH = O_S_RCONV + 128 * 3 * 1024, O_S_WK = O_S_RH + 128 * 1024,
                 O_S_WV = O_S_WK + (size_t)128 * 128 * 256, O_S_FFN = O_S_WV + (size_t)128 * 128 * 256, O_END = O_S_FFN + (size_t)128 * 2 * NUP;
static_assert(O_END == 46850048, "output size");
constexpr size_t MiB = 1u << 20;
constexpr size_t WS_CTL = 0, CTL_BYTES = 1 * MiB;
constexpr size_t CT_SS_RNN = 128 * 1024, CT_SS_ATT = 256 * 1024, CT_SS_H = 384 * 1024, CT_SS_OUT = 512 * 1024;
constexpr size_t CT_PCNT = 736 * 1024;
constexpr size_t CT_BAR3 = 724 * 1024;
constexpr size_t CT_RSTD_X = 512 * 1024;
constexpr size_t CT_BAR2 = 720 * 1024;
constexpr size_t CT_BAR = 640 * 1024;
constexpr size_t WS_WG = 1 * MiB;
constexpr size_t WS_XCH = 3 * MiB + 64 * 1024;
constexpr size_t WS_DUMP = 3 * MiB;
constexpr size_t WS_SUMM = 2 * MiB;
constexpr size_t WS_WIN = 4 * MiB, WS_WOUT = 18 * MiB, WS_WUP = 26 * MiB, WS_WDOWN = 74 * MiB;
constexpr size_t WS_XN = 100 * MiB;
constexpr size_t WS_PROJ = 168 * MiB;
constexpr size_t WS_MERGED = 284 * MiB;
constexpr size_t WS_ACT = 168 * MiB;
constexpr size_t WS_SLAB = 368 * MiB;
constexpr size_t WS_DU = WS_SLAB;
constexpr size_t WS_END = 432 * MiB;
static_assert(WS_ACT + (size_t)MT * DFF * 2 <= WS_END && WS_MERGED + (size_t)MT * DM * 2 <= WS_END && WS_PROJ + (size_t)MT * NPROJ * 2 <= WS_MERGED, "ws map");
constexpr int LDS_BYTES = 147456;
constexpr int LDS_MISC = LDS_BYTES - 256;

__device__ __forceinline__ unsigned pk2(float lo, float hi) { f32x2 v = {lo, hi}; bf16x2_t b = __builtin_convertvector(v, bf16x2_t); return __builtin_bit_cast(unsigned, b); }
__device__ __forceinline__ float bf2f(unsigned short h) { return __uint_as_float((unsigned)h << 16); }
__device__ __forceinline__ float bflo(unsigned w) { return __uint_as_float(w << 16); }
__device__ __forceinline__ float bfhi(unsigned w) { return __uint_as_float(w & 0xffff0000u); }
__device__ __forceinline__ float wave_sum(float v) {
#pragma unroll
    for (int o = 1; o < 64; o <<= 1) v += __shfl_xor(v, o);
    return v;
}
__device__ __forceinline__ float sigmoidf_(float x) { return __builtin_amdgcn_rcpf(1.0f + __builtin_amdgcn_exp2f(-1.4426950408889634f * x)); }
__device__ __forceinline__ float gelu_tanh(float x) {
    const float t = x * (2.3022082f + 0.1029432f * x * x);
    return x * __builtin_amdgcn_rcpf(1.0f + __builtin_amdgcn_exp2f(-t));
}
__device__ __forceinline__ f32x4 gelu_mul4(const f32x4 x, const f32x4 v) {
    const f32x4 t = x * (x * x * 0.1029432f + 2.3022082f);
    f32x4 e; e[0] = __builtin_amdgcn_exp2f(-t[0]); e[1] = __builtin_amdgcn_exp2f(-t[1]); e[2] = __builtin_amdgcn_exp2f(-t[2]); e[3] = __builtin_amdgcn_exp2f(-t[3]);
    const f32x4 d = e + 1.0f;
    f32x4 r; r[0] = __builtin_amdgcn_rcpf(d[0]); r[1] = __builtin_amdgcn_rcpf(d[1]); r[2] = __builtin_amdgcn_rcpf(d[2]); r[3] = __builtin_amdgcn_rcpf(d[3]);
    return (x * v) * r;
}
#define LDS_WAIT() asm volatile("s_waitcnt lgkmcnt(0)" ::: "memory")
#define LDS_BARRIER() do { asm volatile("s_waitcnt lgkmcnt(0)" ::: "memory"); __builtin_amdgcn_s_barrier(); asm volatile("" ::: "memory"); } while (0)

namespace gm {
constexpr unsigned XB_SPIN_CAP_ = 1u << 22;
constexpr int BM = 256, BK = 64, HALF = 128, HTB = HALF * BK * 2, STAGE_BYTES = 8 * HTB, NXCD = 8, WGM = 8;
__host__ __device__ __forceinline__ int lds_byte(int r, int c) { const int st = (r >> 4) * 2 + (c >> 5), rr = r & 15, cc = c & 31, ob = rr * 64 + cc * 2; return st * 1024 + (ob ^ (((ob >> 9) & 1) << 5)); }
__host__ __device__ __forceinline__ void stage_rc(int b, int& R, int& C) { const int st = b / 1024, sb = b % 1024, swz = sb ^ (((sb >> 9) & 1) << 5); R = (st >> 1) * 16 + swz / 64; C = (st & 1) * 32 + (swz % 64) / 2; }
__host__ __device__ __forceinline__ int perm32(int rho) { const int n = rho >> 4, i = rho & 15; return 8 * (i >> 2) + 4 * n + (i & 3); }

struct Unit { int pm, pn; int rowbase, seg; int k0; };
template <int ROWMODE> struct Order {
    int nM, nN, nwg, G, c;
    __device__ void init(int nM_, int nN_, int G_, int c_) { nM = nM_; nN = nN_; nwg = nM * nN; G = G_; c = c_; }
    __device__ bool next(int i, Unit& u) const {
        const long L = (long)i * G + c; if (L >= nwg) return false;
        int wgid = (int)L; { const int q = nwg / NXCD, r = nwg % NXCD, xcd = wgid % NXCD, off = wgid / NXCD; wgid = (xcd < r ? xcd * (q + 1) : r * (q + 1) + (xcd - r) * q) + off; }
        const int nig = WGM * nN, gid = wgid / nig, fm = gid * WGM, gsz = (nM - fm) < WGM ? (nM - fm) : WGM;
        if (ROWMODE == 3) { u.pm = fm + (wgid % nig) / nN; u.pn = (wgid % nig) % nN; }
        else { u.pm = fm + ((wgid % nig) % gsz); u.pn = (wgid % nig) / gsz; }
        u.k0 = 0;
        if (ROWMODE == 0 || ROWMODE == 3) { u.rowbase = u.pm * 256; u.seg = 128; }
        else if (ROWMODE == 1) { const int b = u.pm / 33, pmb = u.pm % 33; u.rowbase = b * SEQ + 252 * pmb - 2; u.seg = 126; }
        else { u.rowbase = MP + 256 * u.pm; u.seg = 128; }
        return true;
    }
};

struct SplitOrder {
    int KS, kper, G, c;
    __device__ void init(int KS_, int kper_, int G_, int c_) { KS = KS_; kper = kper_; G = G_; c = c_; }
    __device__ bool next(int i, Unit& u) const {
        const int L = i * G + c; if (L >= 16 * KS) return false;
        const int tile = L / KS, sp = L % KS;
        u.pm = 64 + (tile >> 3); u.pn = tile & 7; u.rowbase = 256 * u.pm; u.seg = 128; u.k0 = sp * kper; return true;
    }
};

template <class Epi, class Sched>
__device__ __forceinline__ void gemm_phase(LAS unsigned char* lds, const bf16_t* A, const bf16_t* Bt, const int K  , const int nt  , const Sched& S, const Epi& E) {
    const int tid = threadIdx.x, wid = __builtin_amdgcn_readfirstlane(tid >> 6), lane = tid & 63, wr = wid >> 2, wc = wid & 3, fr = lane & 15, fq = lane >> 4;
    unsigned voffA, voffB[2];
    { int R, C; stage_rc(tid * 16, R, C); voffA = (unsigned)(R * K + C) * 2u; }
#pragma unroll
    for (int i = 0; i < 2; ++i) { int R, C; stage_rc(tid * 16 + i * 8192, R, C); const int Rb = Epi::PERM ? ((R & ~31) + perm32(R & 31)) : R; voffB[i] = (unsigned)(Rb * K + C) * 2u; }
    const size_t kstep = (size_t)(BK * 2);
    const size_t hstepB = (size_t)HALF * K * 2, tstepB = 2 * hstepB;
    const size_t hstepA = (size_t)64 * K * 2, rowB = (size_t)K * 2;
    const unsigned ldsw = (unsigned)wid * 1024u;
    const int aoff = lds_byte(wr * 64 + fr, fq * 8), boff = lds_byte(wc * 32 + fr, fq * 8);
#define G_SA(b, h) (((b) * 2 + (h)) * HTB)
#define G_SB(b, h) ((4 + (b) * 2 + (h)) * HTB)
#define G_STAGEB(bufoff, gbase) do { _Pragma("unroll") for (int _i = 0; _i < 2; ++_i) \
        __builtin_amdgcn_global_load_lds((const unsigned*)((const char*)(gbase) + voffB[_i]), (LAS unsigned*)(lds + (bufoff) + ldsw + _i * 8192), 16, 0, 0); } while (0)
#define G_STAGEA(bufoff, gbase, segb) do { \
        __builtin_amdgcn_global_load_lds((const unsigned*)((const char*)(gbase) + voffA), (LAS unsigned*)(lds + (bufoff) + ldsw), 16, 0, 0); \
        __builtin_amdgcn_global_load_lds((const unsigned*)((const char*)(gbase) + (segb) + voffA), (LAS unsigned*)(lds + (bufoff) + ldsw + 8192), 16, 0, 0); } while (0)
#define G_LDA(dst, b, h) do { _Pragma("unroll") for (int m = 0; m < 4; ++m) _Pragma("unroll") for (int k = 0; k < 2; ++k) dst[m][k] = *(const LAS bf16x8*)(lds + G_SA(b, h) + aoff + m * 2048 + k * 1024); } while (0)
#define G_LDB(dst, b, h) do { _Pragma("unroll") for (int n = 0; n < 2; ++n) _Pragma("unroll") for (int k = 0; k < 2; ++k) dst[n][k] = *(const LAS bf16x8*)(lds + G_SB(b, h) + boff + n * 2048 + k * 1024); } while (0)
#define G_MMA(ai, bj, At, Bt_) do { __builtin_amdgcn_s_setprio(3); _Pragma("unroll") for (int m = 0; m < 4; ++m) _Pragma("unroll") for (int n = 0; n < 2; ++n) _Pragma("unroll") for (int k = 0; k < 2; ++k) \
        acc[ai][bj][m][n] = __builtin_amdgcn_mfma_f32_16x16x32_bf16(Bt_[n][k], At[m][k], acc[ai][bj][m][n], 0, 0, 0); __builtin_amdgcn_s_setprio(0); } while (0)
#define G_WAIT_V(n) asm volatile("s_waitcnt vmcnt(" #n ")" ::: "memory")
#define G_WAIT_L(n) asm volatile("s_waitcnt lgkmcnt(" #n ")" ::: "memory")
#define G_BAR __builtin_amdgcn_s_barrier()
#define G_SCHED __builtin_amdgcn_sched_barrier(0)
    Unit cur, nxt; int ui = 0;
    if (!S.next(0, cur)) return;
    f32x4 acc[2][2][4][2];
#pragma unroll
    for (int a = 0; a < 2; ++a)
#pragma unroll
        for (int b = 0; b < 2; ++b)
#pragma unroll
            for (int m = 0; m < 4; ++m)
#pragma unroll
                for (int n = 0; n < 2; ++n) acc[a][b][m][n] = (f32x4){0.f, 0.f, 0.f, 0.f};
    bf16x8 At[4][2], B0[2][2], B1[2][2];
    const char* cA = (const char*)A + (long)cur.rowbase * (long)rowB + (long)cur.k0 * 2; size_t cS = (size_t)cur.seg * rowB;
    const char* cB = (const char*)Bt + (size_t)cur.pn * tstepB + (size_t)cur.k0 * 2;
    E.pre(cur, wid, wr, lane);
    G_STAGEB(G_SB(0, 0), cB); G_STAGEB(G_SB(0, 1), cB + hstepB); G_STAGEA(G_SA(0, 0), cA, cS); G_STAGEA(G_SA(0, 1), cA + hstepA, cS);
    if (wr == 1) G_BAR;
    G_WAIT_V(2); G_BAR;
    G_STAGEB(G_SB(1, 0), cB + kstep); G_STAGEA(G_SA(1, 0), cA + kstep, cS); G_STAGEB(G_SB(1, 1), cB + hstepB + kstep);
    G_WAIT_V(6); G_BAR;
    for (;;) {
        const bool has_next = S.next(ui + 1, nxt);
        const char* nA = has_next ? (const char*)A + (long)nxt.rowbase * (long)rowB + (long)nxt.k0 * 2 : cA; const size_t nS = has_next ? (size_t)nxt.seg * rowB : cS;
        const char* nB = has_next ? (const char*)Bt + (size_t)nxt.pn * tstepB + (size_t)nxt.k0 * 2 : cB;
#pragma clang loop unroll(disable)
        for (int t = 0; t < nt; t += 2) {
            const bool last = (t == nt - 2);
            if constexpr (Epi::MID) { if (t == nt / 2) E.mid(acc, cur, wid, wr, fr); }
            const char* a1 = cA + (size_t)(t + 1) * kstep;
            const char* a2 = last ? nA : cA + (size_t)(t + 2) * kstep; const char* b2 = last ? nB : cB + (size_t)(t + 2) * kstep;
            const size_t s2 = last ? nS : cS;
            const char* a3 = a2 + kstep; const char* b3 = b2 + kstep;
            G_LDB(B0, 0, 0); G_LDB(B1, 0, 1); G_SCHED; G_LDA(At, 0, 0); G_STAGEA(G_SA(1, 1), a1 + hstepA, cS);
            G_WAIT_V(8); G_WAIT_L(0); G_BAR; G_MMA(0, 0, At, B0); G_MMA(0, 1, At, B1); G_BAR; G_SCHED;
            G_LDA(At, 0, 1); G_STAGEB(G_SB(0, 0), b2); G_STAGEB(G_SB(0, 1), b2 + hstepB); G_STAGEA(G_SA(0, 0), a2, s2);
            G_WAIT_V(8); G_WAIT_L(0); G_BAR; G_MMA(1, 0, At, B0); G_MMA(1, 1, At, B1); G_BAR; G_SCHED;
            G_LDB(B0, 1, 0); G_LDB(B1, 1, 1); G_SCHED; G_LDA(At, 1, 0); G_STAGEA(G_SA(0, 1), a2 + hstepA, s2);
            G_WAIT_V(8); G_WAIT_L(0); G_BAR; G_MMA(0, 0, At, B0); G_MMA(0, 1, At, B1); G_BAR; G_SCHED;
            G_LDA(At, 1, 1); G_STAGEB(G_SB(1, 0), b3); G_STAGEB(G_SB(1, 1), b3 + hstepB); G_STAGEA(G_SA(1, 0), a3, s2);
            G_WAIT_V(8); G_WAIT_L(0); G_BAR; G_MMA(1, 0, At, B0); G_MMA(1, 1, At, B1); G_BAR; G_SCHED;
        }
        if (wr == 0) G_BAR;
        { int fr_ = fr, fq_ = fq; asm volatile("" : "+v"(fr_), "+v"(fq_)); E(acc, cur, wid, wr, wc, fr_, fq_); }
        if (!has_next) break;
        E.pre(nxt, wid, wr, lane);
#pragma unroll
        for (int a = 0; a < 2; ++a)
#pragma unroll
            for (int b = 0; b < 2; ++b)
#pragma unroll
                for (int m = 0; m < 4; ++m)
#pragma unroll
                    for (int n = 0; n < 2; ++n) acc[a][b][m][n] = (f32x4){0.f, 0.f, 0.f, 0.f};
        cur = nxt; cA = nA; cS = nS; cB = nB; ++ui;
        if (wr == 1) G_BAR;
    }
    G_WAIT_V(0);
    G_BAR;
#undef G_SA
#undef G_SB
#undef G_STAGEA
#undef G_STAGEB
#undef G_LDA
#undef G_LDB
#undef G_MMA
#undef G_WAIT_V
#undef G_WAIT_L
#undef G_BAR
#undef G_SCHED
}

struct EpiProj {
    static constexpr bool PERM = true, MID = false;
    bf16_t* O; int ldc; const float* rsx; LAS float* tab;
    __device__ __forceinline__ void pre(const Unit& u, int wid, int wr, int lane) const {
        LAS float* T = tab + wid * 128;
#pragma unroll
        for (int k = 0; k < 2; ++k) __builtin_amdgcn_global_load_lds((const unsigned*)(rsx + u.rowbase + u.seg * wr + lane + 64 * k), (LAS unsigned*)(T + 64 * k), 4, 0, 0);
    }
    __device__ __forceinline__ void mid(f32x4 (&)[2][2][4][2], const Unit&, int, int, int) const {}
    __device__ __forceinline__ void operator()(f32x4 (&acc)[2][2][4][2], const Unit& u, int wid, int wr, int wc, int fr, int fq) const {
        const int row0 = u.rowbase + u.seg * wr + fr, col0 = u.pn * BM + wc * 32 + 8 * fq;
        const LAS float* T = tab + wid * 128;
        float rs[8];
#pragma unroll
        for (int g = 0; g < 8; ++g) rs[g] = T[(g >> 2) * 64 + (g & 3) * 16 + fr];
#pragma unroll
        for (int ai = 0; ai < 2; ++ai)
#pragma unroll
            for (int m = 0; m < 4; ++m) { bf16_t* rowp = O + (size_t)(row0 + ai * 64 + m * 16) * ldc + col0; const float f = rs[ai * 4 + m];
#pragma unroll
                for (int bj = 0; bj < 2; ++bj) { const f32x4 v0 = acc[ai][bj][m][0] * f, v1 = acc[ai][bj][m][1] * f;
                    u32x4 w; w.x = pk2(v0[0], v0[1]); w.y = pk2(v0[2], v0[3]); w.z = pk2(v1[0], v1[1]); w.w = pk2(v1[2], v1[3]);
                    *(u32x4*)(rowp + bj * HALF) = w; } }
    }
};
struct EpiH {
    static constexpr bool PERM = false, MID = true;
    const float* xp; const float* xs; bf16_t* HB; const float* ss_rnn; const float* ss_att; float* ss_h; LAS float* tab;
    __device__ __forceinline__ void pre(const Unit& u, int wid, int wr, int lane) const {
        LAS float* T = tab + wid * 256;
#pragma unroll
        for (int i = 0; i < 2; ++i) { const int s = lane + 64 * i, row = u.rowbase + u.seg * wr + s;
            const float sr = __builtin_amdgcn_rsqf(ss_rnn[row] * (1.0f / 1024.0f) + EPS), sa = __builtin_amdgcn_rsqf(ss_att[row] * (1.0f / 1024.0f) + EPS);
            T[s] = sr * __builtin_amdgcn_rcpf(sa); T[128 + s] = sa; }
    }
    __device__ __forceinline__ void mid(f32x4 (&acc)[2][2][4][2], const Unit& u, int wid, int wr, int fr) const {
        const LAS float* T = tab + wid * 256;
#pragma unroll
        for (int ai = 0; ai < 2; ++ai)
#pragma unroll
            for (int m = 0; m < 4; ++m) { const float f = T[64 * ai + 16 * m + fr];
#pragma unroll
                for (int bj = 0; bj < 2; ++bj)
#pragma unroll
                    for (int n = 0; n < 2; ++n) acc[ai][bj][m][n] = acc[ai][bj][m][n] * f; }
    }
    __device__ __forceinline__ void operator()(f32x4 (&acc)[2][2][4][2], const Unit& u, int wid, int wr, int wc, int fr, int fq) const {
        const LAS float* T = tab + wid * 256;
        const int row0 = u.rowbase + u.seg * wr + fr, col0 = u.pn * BM + wc * 32 + 4 * fq;
        const bf16_t* xb = HB + (size_t)row0 * DM + col0;
        u32x2 xv[8][2][2];
#pragma unroll
        for (int g = 0; g < 8; ++g)
#pragma unroll
            for (int bj = 0; bj < 2; ++bj)
#pragma unroll
                for (int n = 0; n < 2; ++n) xv[g][bj][n] = *(const u32x2*)(xb + (size_t)((g >> 2) * 64 + (g & 3) * 16) * DM + bj * HALF + n * 16);
        float q[8];
#pragma unroll
        for (int g = 0; g < 8; ++g) { const int ai = g >> 2, m = g & 3, row = row0 + ai * 64 + m * 16;
            const float sa = T[128 + 64 * ai + 16 * m + fr];
            float qq = 0.f;
#pragma unroll
            for (int bj = 0; bj < 2; ++bj)
#pragma unroll
                for (int n = 0; n < 2; ++n) { const int c = col0 + bj * HALF + n * 16; const u32x2 hw = xv[g][bj][n];
                    f32x4 h = acc[ai][bj][m][n] * sa; h[0] += bflo(hw.x); h[1] += bfhi(hw.x); h[2] += bflo(hw.y); h[3] += bfhi(hw.y);
                    u32x2 w; w.x = pk2(h[0], h[1]); w.y = pk2(h[2], h[3]); *(u32x2*)(HB + (size_t)row * DM + c) = w;
                    qq += (h[0] * h[0] + h[1] * h[1]) + (h[2] * h[2] + h[3] * h[3]); }
            q[g] = qq; }
#pragma unroll
        for (int g = 0; g < 8; ++g) { float s = q[g]; s += __shfl_xor(s, 16); s += __shfl_xor(s, 32);
            if (fq == 0) atomicAdd(ss_h + row0 + (g >> 2) * 64 + (g & 3) * 16, s); }
    }
};
struct EpiOutNorm {
    static constexpr bool PERM = false, MID = false;
    const bf16_t* HB; float* Y; const float* gfin; float* xch; unsigned* pcnt; unsigned* tmo; LAS float* tab;
    __device__ __forceinline__ void pre(const Unit&, int, int, int) const {}
    __device__ __forceinline__ void mid(f32x4 (&)[2][2][4][2], const Unit&, int, int, int) const {}
    __device__ __forceinline__ void operator()(f32x4 (&acc)[2][2][4][2], const Unit& u, int wid, int wr, int wc, int fr, int fq) const {
        const int lane = fq * 16 + fr, tid = wid * 64 + lane;
        const int row0 = u.rowbase + u.seg * wr + fr, col0 = u.pn * BM + wc * 32 + 4 * fq;
        const bf16_t* hb = HB + (size_t)row0 * DM + col0;
        LAS float* P = tab; LAS float* S = tab + 1024;
        u32x2 hv[8][2][2];
#pragma unroll
        for (int g = 0; g < 8; ++g)
#pragma unroll
            for (int bj = 0; bj < 2; ++bj)
#pragma unroll
                for (int n = 0; n < 2; ++n) hv[g][bj][n] = *(const u32x2*)(hb + (size_t)((g >> 2) * 64 + (g & 3) * 16) * DM + bj * HALF + n * 16);
        f32x4 gg[2][2];
#pragma unroll
        for (int bj = 0; bj < 2; ++bj)
#pragma unroll
            for (int n = 0; n < 2; ++n) gg[bj][n] = *(const f32x4*)(gfin + col0 + bj * HALF + n * 16);
#pragma unroll
        for (int g = 0; g < 8; ++g) { const int ai = g >> 2, m = g & 3;
            float q = 0.f;
#pragma unroll
            for (int bj = 0; bj < 2; ++bj)
#pragma unroll
                for (int n = 0; n < 2; ++n) { const u32x2 hw = hv[g][bj][n]; f32x4 o = acc[ai][bj][m][n];
                    o[0] += bflo(hw.x); o[1] += bfhi(hw.x); o[2] += bflo(hw.y); o[3] += bfhi(hw.y); acc[ai][bj][m][n] = o;
                    q += (o[0] * o[0] + o[1] * o[1]) + (o[2] * o[2] + o[3] * o[3]); }
            q += __shfl_xor(q, 16); q += __shfl_xor(q, 32);
            if (fq == 0) P[(wr * 128 + ai * 64 + m * 16 + fr) * 4 + wc] = q; }
        LDS_BARRIER();
        if (tid < 256) { const f32x4 p4 = *(const LAS f32x4*)(P + tid * 4); const float part = (p4[0] + p4[1]) + (p4[2] + p4[3]);
            unsigned* sl = (unsigned*)(xch + ((size_t)u.pm * 256 + tid) * 8);
            __hip_atomic_store(sl + u.pn, __float_as_uint(part) | 0x80000000u, __ATOMIC_RELAXED, __HIP_MEMORY_SCOPE_AGENT);
            unsigned sp = 0; float ssum = 0.f;
            for (;;) { unsigned v[8]; unsigned all = 0x80000000u;
#pragma unroll
                for (int t = 0; t < 8; ++t) { v[t] = __hip_atomic_load(sl + t, __ATOMIC_RELAXED, __HIP_MEMORY_SCOPE_AGENT); all &= v[t]; }
                ssum = 0.f;
#pragma unroll
                for (int t = 0; t < 8; ++t) ssum += __uint_as_float(v[t] & 0x7fffffffu);
                if (all) break;
                __builtin_amdgcn_s_sleep(2);
                if (++sp > (1u << 18)) { atomicAdd(tmo, 1u); break; } }
            S[tid] = __builtin_amdgcn_rsqf(ssum * (1.0f / DM) + EPS); }
        LDS_BARRIER();
        float* yb = Y + (size_t)row0 * DM + col0;
#pragma unroll
        for (int g = 0; g < 8; ++g) { const int ai = g >> 2, m = g & 3; const float rs = S[wr * 128 + ai * 64 + m * 16 + fr];
#pragma unroll
            for (int bj = 0; bj < 2; ++bj)
#pragma unroll
                for (int n = 0; n < 2; ++n) *(f32x4*)(yb + (size_t)(ai * 64 + m * 16) * DM + bj * HALF + n * 16) = acc[ai][bj][m][n] * rs * gg[bj][n]; }
        LDS_WAIT();
    }
};
template <bool SCALED> struct EpiSlab {
    static constexpr bool PERM = false, MID = false;
    float* slab; int kper; const float* ss_rnn; const float* ss_att; LAS float* tab;
    __device__ __forceinline__ void pre(const Unit& u, int wid, int wr, int lane) const {
        if (SCALED) { LAS float* T = tab + wid * 256; const float* ss = (u.k0 < DRNN) ? ss_rnn : ss_att;
#pragma unroll
            for (int i = 0; i < 2; ++i) __builtin_amdgcn_global_load_lds((const unsigned*)(ss + u.rowbase + u.seg * wr + lane + 64 * i), (LAS unsigned*)(T + 64 * i), 4, 0, 0); }
    }
    __device__ __forceinline__ void mid(f32x4 (&)[2][2][4][2], const Unit&, int, int, int) const {}
    __device__ __forceinline__ void operator()(f32x4 (&acc)[2][2][4][2], const Unit& u, int wid, int wr, int wc, int fr, int fq) const {
        const LAS float* T = tab + wid * 256;
        const int row0 = u.rowbase - MP + u.seg * wr + fr, col0 = u.pn * BM + wc * 32 + 4 * fq;
        float* S = slab + (size_t)(u.k0 / kper) * MS * DM;
#pragma unroll
        for (int ai = 0; ai < 2; ++ai)
#pragma unroll
            for (int m = 0; m < 4; ++m) { const int row = row0 + ai * 64 + m * 16; const float sc = SCALED ? __builtin_amdgcn_rsqf(T[64 * ai + 16 * m + fr] * (1.0f / 1024.0f) + EPS) : 1.0f;
#pragma unroll
                for (int bj = 0; bj < 2; ++bj)
#pragma unroll
                    for (int n = 0; n < 2; ++n) *(f32x4*)(S + (size_t)row * DM + col0 + bj * HALF + n * 16) = acc[ai][bj][m][n] * sc; }
    }
};
__device__ __forceinline__ float dpp_shr1(float oldv, float src) { return __builtin_bit_cast(float, __builtin_amdgcn_update_dpp(__builtin_bit_cast(int, oldv), __builtin_bit_cast(int, src), 0x111, 0xf, 0xf, false)); }
__device__ __forceinline__ float dpp_shr2(float oldv, float src) { return __builtin_bit_cast(float, __builtin_amdgcn_update_dpp(__builtin_bit_cast(int, oldv), __builtin_bit_cast(int, src), 0x112, 0xf, 0xf, false)); }
__device__ __forceinline__ float dpp_ror1(float src) { return __builtin_bit_cast(float, __builtin_amdgcn_update_dpp(0, __builtin_bit_cast(int, src), 0x121, 0xf, 0xf, false)); }
__device__ __forceinline__ float dpp_ror2(float src) { return __builtin_bit_cast(float, __builtin_amdgcn_update_dpp(0, __builtin_bit_cast(int, src), 0x122, 0xf, 0xf, false)); }
__device__ __forceinline__ void conv_taps_dpp(f32x4& upc, const f32x4 X, const f32x4 Xp, const f32x4 w1, const f32x4 w1m, const f32x4 w0, const f32x4 w0m) {
#define CT_E(e) asm volatile("s_nop 1\n\t" \
        "v_fmac_f32_dpp %0, %1, %3 row_shr:1 row_mask:0xf bank_mask:0xf bound_ctrl:1\n\t" \
        "v_fmac_f32_dpp %0, %2, %4 row_ror:1 row_mask:0xf bank_mask:0xf bound_ctrl:1\n\t" \
        "v_fmac_f32_dpp %0, %1, %5 row_shr:2 row_mask:0xf bank_mask:0xf bound_ctrl:1\n\t" \
        "v_fmac_f32_dpp %0, %2, %6 row_ror:2 row_mask:0xf bank_mask:0xf bound_ctrl:1" \
        : "+v"(u##e) : "v"(x##e), "v"(p##e), "v"(a##e), "v"(b##e), "v"(c##e), "v"(d##e))
    float u0 = upc[0], u1 = upc[1], u2 = upc[2], u3 = upc[3];
    const float x0 = X[0], x1 = X[1], x2 = X[2], x3 = X[3], p0 = Xp[0], p1 = Xp[1], p2 = Xp[2], p3 = Xp[3];
    const float a0 = w1[0], a1 = w1[1], a2 = w1[2], a3 = w1[3], b0 = w1m[0], b1 = w1m[1], b2 = w1m[2], b3 = w1m[3];
    const float c0 = w0[0], c1 = w0[1], c2 = w0[2], c3 = w0[3], d0 = w0m[0], d1 = w0m[1], d2 = w0m[2], d3 = w0m[3];
    CT_E(0); CT_E(1); CT_E(2); CT_E(3);
    upc = (f32x4){u0, u1, u2, u3};
#undef CT_E
}
template <bool SAMPLE> struct EpiAct {
    static constexpr bool PERM = true, MID = false;
    bf16_t* ACT; const float* ss_h; const float* cw; const float* cb; const float* st_ffn; float* o_p_ffn; float* o_s_ffn; unsigned char* wsb; LAS float* tab;
    __device__ __forceinline__ void pre(const Unit& u, int wid, int wr, int lane) const {
        LAS float* T = tab + wid * 384;
        { const int a = lane >> 4, bj = (lane >> 3) & 1, i = lane & 7, wc = wid & 3;
          const float* srcp = (a < 3 ? cw + (size_t)a * NUP : cb) + bj * DFF + u.pn * 128 + wc * 32 + 4 * i;
          __builtin_amdgcn_global_load_lds((const unsigned*)srcp, (LAS unsigned*)T, 16, 0, 0); }
#pragma unroll
        for (int k = 0; k < 2; ++k) { const int s = lane + 64 * k, row = u.rowbase + u.seg * wr + s;
            __builtin_amdgcn_global_load_lds((const unsigned*)(ss_h + (row < 0 ? 0 : row)), (LAS unsigned*)(T + 256 + 64 * k), 4, 0, 0); }
    }
    __device__ __forceinline__ void mid(f32x4 (&)[2][2][4][2], const Unit&, int, int, int) const {}
    __device__ __forceinline__ void operator()(f32x4 (&acc)[2][2][4][2], const Unit& u, int wid, int wr, int wc, int fr, int fq) const {
        constexpr bool sample = SAMPLE;
        const int segrow0 = u.rowbase + u.seg * wr;
        const int jcol = u.pn * 128 + wc * 32 + 8 * fq;
        const int bstart = sample ? 0 : (u.pm / 33) * SEQ;
        const unsigned dump_off = (unsigned)WS_DUMP + (unsigned)(wid * 64 + fq * 16 + fr) * 16u;
        const unsigned act_off = (unsigned)WS_ACT + (unsigned)segrow0 * (unsigned)(DFF * 2) + (unsigned)jcol * 2u;
        const int smax = SEQ - (segrow0 - bstart);
        const LAS float* T = tab + wid * 384;
#pragma unroll
        for (int ai = 0; ai < 2; ++ai)
#pragma unroll
            for (int m = 0; m < 4; ++m) { float rs = __builtin_amdgcn_rsqf(T[256 + 64 * ai + 16 * m + fr] * (1.0f / 2048.0f) + EPS);
                if (!sample && segrow0 + 64 * ai + 16 * m + fr < bstart) rs = 0.f;
#pragma unroll
                for (int bj = 0; bj < 2; ++bj)
#pragma unroll
                    for (int n = 0; n < 2; ++n) acc[ai][bj][m][n] = acc[ai][bj][m][n] * rs; }
        if constexpr (sample) {
            const int tt = fr & 3;
#pragma unroll
            for (int ai = 0; ai < 2; ++ai)
#pragma unroll
                for (int m = 0; m < 4; ++m) { const int row = segrow0 + ai * 64 + m * 16 + fr, sq = (row - MP) >> 2;
                    if (tt >= 2) {
#pragma unroll
                        for (int bj = 0; bj < 2; ++bj)
#pragma unroll
                            for (int n = 0; n < 2; ++n) *(f32x4*)(o_s_ffn + ((size_t)sq * 2 + (tt - 2)) * NUP + bj * DFF + jcol + 4 * n) = acc[ai][bj][m][n]; } }
            asm volatile("" ::: "memory");
#pragma unroll
            for (int n = 0; n < 2; ++n)
#pragma unroll
            for (int pass = 0; pass < 2; ++pass) {
                const int bj = 1 - pass, c = bj * DFF + jcol + 4 * n, ti = (bj * 8 + 2 * fq + n) * 4;
                const f32x4 w0 = *(const LAS f32x4*)(T + ti), w1 = *(const LAS f32x4*)(T + 64 + ti), w2 = *(const LAS f32x4*)(T + 128 + ti), bb = *(const LAS f32x4*)(T + 192 + ti);
                const f32x4 zero4 = {0.f, 0.f, 0.f, 0.f};
                const f32x4 w1z = (tt == 0) ? w1 : zero4, w1n = (tt == 0) ? zero4 : w1, w0z = (tt < 2) ? w0 : zero4, w0n = (tt < 2) ? zero4 : w0;
#pragma unroll
                for (int ai = 0; ai < 2; ++ai) {
                    f32x4 sA4[4], sB4[4];
#pragma unroll
                    for (int m = 0; m < 4; ++m) { const int sq = (segrow0 + ai * 64 + m * 16 + fr - MP) >> 2;
                        const float* sp = st_ffn + ((size_t)sq * 2 + 1) * NUP + c;
                        sB4[m] = *(const f32x4*)(sp);
                        sA4[m] = *(const f32x4*)(sp - (tt == 0 ? NUP : 0)); }
#pragma unroll
                    for (int m = 0; m < 4; ++m) {
                    const int row = segrow0 + ai * 64 + m * 16 + fr;
                    const f32x4 X = acc[ai][bj][m][n];
                    f32x4 upc = bb + w2 * X + w1z * sB4[m] + w0z * sA4[m];
#pragma unroll
                    for (int e = 0; e < 4; ++e) { float ue = upc[e]; const float xe = X[e], a1 = w1n[e], a0 = w0n[e];
                        asm volatile("s_nop 1\n\t"
                                     "v_fmac_f32_dpp %0, %1, %2 row_shr:1 row_mask:0xf bank_mask:0xf bound_ctrl:1\n\t"
                                     "v_fmac_f32_dpp %0, %1, %3 row_shr:2 row_mask:0xf bank_mask:0xf bound_ctrl:1"
                                     : "+v"(ue) : "v"(xe), "v"(a1), "v"(a0));
                        upc[e] = ue; }
                    if (pass == 0) acc[ai][1][m][n] = upc;
                    else {
                        upc = gelu_mul4(upc, acc[ai][1][m][n]);
                        u32x2 w; w.x = pk2(upc[0], upc[1]); w.y = pk2(upc[2], upc[3]); *(u32x2*)(ACT + (size_t)row * DFF + jcol + 4 * n) = w;
                    }
                    asm volatile("" ::: "memory");
                    __builtin_amdgcn_sched_barrier(0);
                    }
                }
            }
        } else {
            if (u.pm % 33 == 32) {
#pragma unroll
                for (int ai = 0; ai < 2; ++ai)
#pragma unroll
                    for (int m = 0; m < 4; ++m) { const int s = 64 * ai + 16 * m + fr, tl = segrow0 + s - bstart;
                        if (s >= 2 && (tl == SEQ - 2 || tl == SEQ - 1)) {
#pragma unroll
                            for (int bj = 0; bj < 2; ++bj)
#pragma unroll
                                for (int n = 0; n < 2; ++n) *(f32x4*)(o_p_ffn + ((size_t)(u.pm / 33) * 2 + (tl - (SEQ - 2))) * NUP + bj * DFF + jcol + 4 * n) = acc[ai][bj][m][n]; } }
                asm volatile("" ::: "memory");
            }
#pragma unroll
            for (int n = 0; n < 2; ++n)
#pragma unroll
            for (int pass = 0; pass < 2; ++pass) {
                const int bj = 1 - pass, c = bj * DFF + jcol + 4 * n, ti = (bj * 8 + 2 * fq + n) * 4;
                const f32x4 w0 = *(const LAS f32x4*)(T + ti), w1 = *(const LAS f32x4*)(T + 64 + ti), w2 = *(const LAS f32x4*)(T + 128 + ti), bb = *(const LAS f32x4*)(T + 192 + ti);
                const f32x4 w1m = (fr == 0) ? w1 : (f32x4){0.f, 0.f, 0.f, 0.f}, w0m = (fr < 2) ? w0 : (f32x4){0.f, 0.f, 0.f, 0.f};
#pragma unroll
                for (int g = 7; g >= 0; --g) { const int ai = g >> 2, m = g & 3, gp = (g > 0 ? g - 1 : 0);
                    const int s = 64 * ai + 16 * m + fr;
                    const f32x4 X = acc[ai][bj][m][n];
                    const f32x4 Xp = acc[gp >> 2][bj][gp & 3][n];
                    f32x4 upc = bb + w2 * X;
                    conv_taps_dpp(upc, X, Xp, w1, w1m, w0, w0m);
                    if (pass == 0) acc[ai][1][m][n] = upc;
                    else {
                        upc = gelu_mul4(upc, acc[ai][1][m][n]);
                        const unsigned px = pk2(upc[0], upc[1]), py = pk2(upc[2], upc[3]);
                        if (n == 0) { acc[ai][1][m][0][0] = __uint_as_float(px); acc[ai][1][m][0][1] = __uint_as_float(py); }
                        else {
                            const bool ok = (g > 0 || fr >= 2) && (s < smax);
                            const unsigned off = ok ? (act_off + (unsigned)s * (unsigned)(DFF * 2)) : dump_off;
                            *(u32x4*)(wsb + off) = (u32x4){__float_as_uint(acc[ai][1][m][0][0]), __float_as_uint(acc[ai][1][m][0][1]), px, py};
                        }
                    }
                    __builtin_amdgcn_sched_barrier(0);
                }
                asm volatile("" ::: "memory");
            }
        }
    }
};
}


#define XB_TMO      128
#define XB_XCNT(j)  (256  + 64 * (j))
#define XB_XSUB(j)  (1280 + 64 * (j))
#define XB_XGEN(j)  (2304 + 64 * (j))
#define XB_TOP      3328
#define XB_TOPGEN   3392
#define XCD_BAR_WORDS 3456
#define XB_SPIN_CAP (1u << 22)
__device__ __forceinline__ unsigned xb_ld(unsigned* p)              { return __hip_atomic_load(p, __ATOMIC_RELAXED, __HIP_MEMORY_SCOPE_AGENT); }
__device__ __forceinline__ unsigned xb_add(unsigned* p, unsigned v) { return __hip_atomic_fetch_add(p, v, __ATOMIC_RELAXED, __HIP_MEMORY_SCOPE_AGENT); }
__device__ __forceinline__ unsigned xb_xcc_id() { return (unsigned)__builtin_amdgcn_s_getreg((3 << 11) | 20) & 0xFu; }
#define XB_SPIN(cond, bar) do { unsigned _sp = 0; while (cond) { __builtin_amdgcn_s_sleep(1); \
    if ((++_sp & 255u) == 0u) { if (xb_ld(&(bar)[XB_TMO])) break; if (_sp > XB_SPIN_CAP) { atomicAdd(&(bar)[XB_TMO], 1u); break; } } } } while (0)
struct XcdBarrier { unsigned* bar; unsigned x; volatile LAS unsigned* st; };
__device__ __forceinline__ XcdBarrier xcd_barrier_post(unsigned* bar, volatile LAS unsigned* st) {
    XcdBarrier b; b.bar = bar; b.x = xb_xcc_id(); b.st = st;
    if (threadIdx.x == 0) (void)xb_add(&bar[XB_XCNT(b.x)], 1u);
    return b;
}
__device__ __forceinline__ void xcd_barrier_complete(unsigned* bar, unsigned x, unsigned& nloc, unsigned& nx) {
    const unsigned G = gridDim.x * gridDim.y * gridDim.z;
    unsigned sum, cnt, mine, sp = 0u;
    for (;;) {
        sum = 0u; cnt = 0u; mine = 0u;
#pragma unroll
        for (unsigned j = 0; j < 16; ++j) { const unsigned c = xb_ld(&bar[XB_XCNT(j)]); sum += c; cnt += (c > 0u) ? 1u : 0u; mine = (j == x) ? c : mine; }
        if (sum == G) break;
        __builtin_amdgcn_s_sleep(1);
        if ((++sp & 255u) == 0u) { if (xb_ld(&bar[XB_TMO])) break; if (sp > XB_SPIN_CAP) { atomicAdd(&bar[XB_TMO], 1u); break; } }
    }
    nloc = mine > 0u ? mine : 1u; nx = cnt > 0u ? cnt : 1u;
}
__device__ __forceinline__ void xcd_barrier(const XcdBarrier& b) {
    asm volatile("s_waitcnt vmcnt(0)" ::: "memory");
    __syncthreads();
    if (threadIdx.x == 0) {
        unsigned* bar = b.bar;
        __builtin_amdgcn_s_waitcnt(0);
        unsigned nloc = b.st[0], nx = b.st[1];
        if (nloc == 0u) { xcd_barrier_complete(bar, b.x, nloc, nx); b.st[0] = nloc; b.st[1] = nx; }
        const unsigned old = xb_add(&bar[XB_XSUB(b.x)], 1u);
        const unsigned gen = old / nloc;
        if (old + 1u == (gen + 1u) * nloc) {
            __builtin_amdgcn_fence(__ATOMIC_RELEASE, "agent");
            asm volatile("s_waitcnt vmcnt(0)" ::: "memory");
            const unsigned og = xb_add(&bar[XB_TOP], 1u);
            const unsigned tg = og / nx;
            if (og + 1u == (tg + 1u) * nx) xb_add(&bar[XB_TOPGEN], 1u);
            else XB_SPIN(xb_ld(&bar[XB_TOPGEN]) == tg, bar);
            __builtin_amdgcn_fence(__ATOMIC_ACQUIRE, "agent");
            xb_add(&bar[XB_XGEN(b.x)], 1u);
            asm volatile("s_waitcnt vmcnt(0)" ::: "memory");
        } else {
            XB_SPIN(xb_ld(&bar[XB_XGEN(b.x)]) == gen, bar);
            __builtin_amdgcn_fence(__ATOMIC_ACQUIRE, "agent");
            asm volatile("s_waitcnt vmcnt(0)" ::: "memory");
        }
    }
    __syncthreads();
}


__device__ __forceinline__ void split_arrive(unsigned* cnt) {
    asm volatile("s_waitcnt vmcnt(0)" ::: "memory");
    __syncthreads();
    if (threadIdx.x == 0) { __builtin_amdgcn_fence(__ATOMIC_RELEASE, "agent"); asm volatile("s_waitcnt vmcnt(0)" ::: "memory"); (void)xb_add(cnt, 1u); }
}
__device__ __forceinline__ void split_wait(unsigned* cnt, unsigned* tmo, unsigned target = 0u) {
    if (threadIdx.x == 0) { const unsigned G = target ? target : gridDim.x; unsigned sp = 0;
        while (xb_ld(cnt) < G) { __builtin_amdgcn_s_sleep(1); if ((++sp & 255u) == 0u) { if (xb_ld(tmo)) break; if (sp > XB_SPIN_CAP) { atomicAdd(tmo, 1u); break; } } }
        __builtin_amdgcn_fence(__ATOMIC_ACQUIRE, "agent"); asm volatile("s_waitcnt vmcnt(0)" ::: "memory"); }
    __syncthreads();
}

struct Args {
    const float* in[27]; float* out; unsigned char* ws; int ph_lo, ph_hi;
};
struct Ctx {
    LAS unsigned char* lds; int tid, lane, wave, bid, G;
    const float* const* in; float* out; unsigned char* ws;
};

template <bool UPMAP>
__device__ __forceinline__ void p0_transpose_item(const float* W, int K, int N, bf16_t* WT, const float* gk, LAS unsigned char* scr, int item, int lane) {
    const int nblk = N / 64, kb = item / nblk, nb = item % nblk, k0 = 64 * kb, n0 = 64 * nb;
    const int n4 = lane & 15, kg = lane >> 4;
    f32x4 v[4][4];
#pragma unroll
    for (int i = 0; i < 4; ++i)
#pragma unroll
        for (int j = 0; j < 4; ++j) v[i][j] = *(const f32x4*)(W + (size_t)(k0 + 16 * i + 4 * kg + j) * N + n0 + 4 * n4);
    if (gk) {
#pragma unroll
        for (int i = 0; i < 4; ++i) { const f32x4 g4 = *(const f32x4*)(gk + k0 + 16 * i + 4 * kg);
#pragma unroll
            for (int j = 0; j < 4; ++j) v[i][j] = v[i][j] * g4[j]; } }
#pragma unroll
    for (int i = 0; i < 4; ++i) {
        const int q = 4 * i + kg;
#pragma unroll
        for (int e = 0; e < 4; ++e) { const int n = 4 * n4 + e; u32x2 w; w.x = pk2(v[i][0][e], v[i][1][e]); w.y = pk2(v[i][2][e], v[i][3][e]);
            *(LAS u32x2*)(scr + n * 128 + ((q ^ n4) * 8)) = w; }
    }
    LDS_WAIT(); asm volatile("" ::: "memory");
    int d0 = n0;
    if (UPMAP) d0 = (n0 < DFF) ? (256 * (n0 / 128) + (n0 % 128)) : (256 * ((n0 - DFF) / 128) + 128 + ((n0 - DFF) % 128));
    const int c16 = lane & 7;
#pragma unroll
    for (int p = 0; p < 8; ++p) { const int n = (lane >> 3) + 8 * p, s = (n >> 2) & 15, pos = (2 * c16) ^ s;
        u32x4 r = *(const LAS u32x4*)(scr + n * 128 + (pos & ~1) * 8);
        if (s & 1) r = (u32x4){r.z, r.w, r.x, r.y};
        *(u32x4*)(WT + (size_t)(d0 + n) * K + k0 + 8 * c16) = r; }
    LDS_WAIT(); asm volatile("" ::: "memory");
}
__device__ __forceinline__ void convert_weights(const Ctx& F, int which, int part, int nparts) {
    LAS unsigned char* scr = F.lds + F.wave * 16384;
    const int gw = part * NWAVES + F.wave, NGW = nparts * NWAVES;
    bf16_t* WIN = (bf16_t*)(F.ws + WS_WIN); bf16_t* WOUT = (bf16_t*)(F.ws + WS_WOUT); bf16_t* WUP = (bf16_t*)(F.ws + WS_WUP); bf16_t* WDOWN = (bf16_t*)(F.ws + WS_WDOWN);
    constexpr int I_IN = (DM / 64) * (NPROJ / 64), I_OUT = (DM / 64) * (DM / 64), I_UP = (DM / 64) * (NUP / 64), I_DOWN = (DFF / 64) * (DM / 64);
    if (which & 1) for (int r = gw; r < I_IN; r += NGW) p0_transpose_item<false>(F.in[8], DM, NPROJ, WIN, F.in[7], scr, r, F.lane);
    if (which & 2) for (int r = gw; r < I_OUT; r += NGW) {
        const int nblk = DM / 64, kb = r / nblk; const float* g = (kb < 16) ? F.in[18] : (F.in[19] - 1024);
        p0_transpose_item<false>(F.in[20], DM, DM, WOUT, g, scr, r, F.lane); }
    if (which & 4) for (int r = gw; r < I_UP; r += NGW) p0_transpose_item<true>(F.in[22], DM, NUP, WUP, F.in[21], scr, r, F.lane);
    constexpr int I_DOWN_A = (I_DOWN * 5) / 8;
    if (which & 8) for (int r = gw; r < I_DOWN_A; r += NGW) p0_transpose_item<false>(F.in[25], DFF, DM, WDOWN, nullptr, scr, r, F.lane);
    if (which & 16) for (int r = I_DOWN_A + gw; r < I_DOWN; r += NGW) p0_transpose_item<false>(F.in[25], DFF, DM, WDOWN, nullptr, scr, r, F.lane);
}
__device__ __forceinline__ void p0_prologue(const Ctx& F) {
    const int gw = F.bid * NWAVES + F.wave, NGW = F.G * NWAVES;
    convert_weights(F, 1, F.bid, F.G);
    { unsigned* xz = (unsigned*)(F.ws + WS_XCH); const int gt = F.bid * NTHREADS + F.tid, NGT = F.G * NTHREADS;
      for (int i = gt; i < 64 * 256 * 8; i += NGT) __hip_atomic_store(xz + i, 0u, __ATOMIC_RELAXED, __HIP_MEMORY_SCOPE_AGENT); }
    { bf16_t* WG = (bf16_t*)(F.ws + WS_WG); const int gt = F.bid * NTHREADS + F.tid, NGT = F.G * NTHREADS;
      for (int idx = gt; idx < 16 * 128 * 64; idx += NGT) { const int blk = idx >> 13, n = (idx >> 6) & 127, k = idx & 63;
          const float v = (n < 64) ? F.in[11][(blk * 64 + k) * 64 + n] : F.in[13][(blk * 64 + k) * 64 + (n - 64)];
          WG[idx] = (bf16_t)(pk2(v, 0.f) & 0xffffu); } }
    if (gw == 0) { u32x4* z = (u32x4*)(F.ws + WS_XN - 2 * DM * 2);
#pragma unroll
        for (int j = 0; j < 8; ++j) z[F.lane + 64 * j] = (u32x4){0u, 0u, 0u, 0u}; }
    { bf16_t* XN = (bf16_t*)(F.ws + WS_XN); float* RSX = (float*)(F.ws + CT_RSTD_X);
      for (int m = gw; m < MT; m += NGW) {
          const float* xr = (m < MP) ? F.in[0] + (size_t)m * DM : F.in[1] + (size_t)(m - MP) * DM;
          f32x4 v[8]; float s = 0.f;
#pragma unroll
          for (int j = 0; j < 8; ++j) { v[j] = *(const f32x4*)(xr + 4 * (F.lane + 64 * j)); s += (v[j][0] * v[j][0] + v[j][1] * v[j][1]) + (v[j][2] * v[j][2] + v[j][3] * v[j][3]); }
#pragma unroll
          for (int j = 0; j < 8; ++j) { const f32x4 o = v[j];
              u32x2 w; w.x = pk2(o[0], o[1]); w.y = pk2(o[2], o[3]); *(u32x2*)(XN + (size_t)m * DM + 4 * (F.lane + 64 * j)) = w; }
          const float rstd = __builtin_amdgcn_rsqf(wave_sum(s) * (1.0f / DM) + EPS);
          if (F.lane == 0) RSX[m] = rstd; } }
}

__device__ __forceinline__ f32x4 ld_bf4(const bf16_t* p) { const u32x2 w = *(const u32x2*)p; return (f32x4){bflo(w.x), bfhi(w.x), bflo(w.y), bfhi(w.y)}; }
__device__ __forceinline__ void p2_copies(const Ctx& F, int part, int nparts) {
    const bf16_t* PROJ = (const bf16_t*)(F.ws + WS_PROJ);
    const int gt = part * NTHREADS + F.tid, NGT = nparts * NTHREADS;
    for (int base = gt; base < 2 * 128 * 128 * 64; base += 8 * NGT) {
        f32x4 v[8];
#pragma unroll
        for (int t = 0; t < 8; ++t) { const int idx = base + t * NGT; v[t] = (f32x4){0.f, 0.f, 0.f, 0.f};
            if (idx < 2 * 128 * 128 * 64) { const int kv = idx / (128 * 128 * 64), r = idx % (128 * 128 * 64), s = r / (128 * 64), w = (r / 64) % 128, c4 = r % 64;
                if (w < 124) v[t] = *(const f32x4*)(F.in[4 + kv] + ((size_t)(s * 128 + w + 4)) * 256 + 4 * c4);
                else v[t] = ld_bf4(PROJ + (size_t)(MP + 4 * s + (w - 124)) * NPROJ + (kv ? COL_V : COL_K) + 4 * c4); } }
#pragma unroll
        for (int t = 0; t < 8; ++t) { const int idx = base + t * NGT;
            if (idx < 2 * 128 * 128 * 64) { const int kv = idx / (128 * 128 * 64), r = idx % (128 * 128 * 64); *(f32x4*)(F.out + (kv ? O_S_WV : O_S_WK) + (size_t)r * 4) = v[t]; } }
    }
    for (int idx = gt; idx < 2 * 2 * 128 * 64; idx += NGT) {
        const int kv = idx / (2 * 128 * 64), r = idx % (2 * 128 * 64), b = r / (128 * 64), w = (r / 64) % 128, c4 = r % 64;
        *(f32x4*)(F.out + (kv ? O_P_WV : O_P_WK) + (size_t)r * 4) = ld_bf4(PROJ + (size_t)(b * SEQ + SEQ - 128 + w) * NPROJ + (kv ? COL_V : COL_K) + 4 * c4);
    }
    for (int idx = gt; idx < 2 * 3 * 256; idx += NGT) { const int b = idx / (3 * 256), j = (idx / 256) % 3, c4 = idx % 256;
        *(f32x4*)(F.out + O_P_RCONV + (size_t)idx * 4) = ld_bf4(PROJ + (size_t)(b * SEQ + SEQ - 3 + j) * NPROJ + COL_XR + 4 * c4); }
    for (int idx = gt; idx < 128 * 3 * 256; idx += NGT) { const int s = idx / (3 * 256), j = (idx / 256) % 3, c4 = idx % 256;
        *(f32x4*)(F.out + O_S_RCONV + (size_t)idx * 4) = ld_bf4(PROJ + (size_t)(MP + 4 * s + 1 + j) * NPROJ + COL_XR + 4 * c4); }
}

constexpr int R_WGL = 0, R_WAVE = 18432, R_WSTRIDE = 5120, R_XCBW = 2688, R_WT = 59392, R_PART = 67584, R_HIN = 75776, R_END = 77824;
template <int MODE>
__device__ __forceinline__ void rnn_phase(const Ctx& F, int n_units) {
    const bf16_t* PROJ = (const bf16_t*)(F.ws + WS_PROJ);
    const int tid = F.tid, lane = F.lane, w = F.wave, l15 = lane & 15, q = lane >> 4;
    LAS bf16_t* WGL = (LAS bf16_t*)(F.lds + R_WGL);
    LAS bf16_t* XBw = (LAS bf16_t*)(F.lds + R_WAVE + w * R_WSTRIDE); LAS bf16_t* XCBw = (LAS bf16_t*)(F.lds + R_WAVE + w * R_WSTRIDE + R_XCBW);
    LAS float* HINw = (LAS float*)(F.lds + R_HIN) + w * 64;
    int cur_blk = -1, par = 0;
    LDS_BARRIER();
    u32x4 n_vx[3], n_du[4]; u32x2 n_gv[4]; f32x2 n_sv[8];
#define RNN_DECODE(unit_, b_, c_, blk_, row0_) do { if (MODE == 2) { blk_ = (unit_) & 15; c_ = (unit_) >> 4; b_ = 0; row0_ = MP + 128 * c_; } \
        else { blk_ = (unit_) & 15; c_ = ((unit_) >> 4) & 63; b_ = (unit_) >> 10; row0_ = b_ * SEQ + 128 * c_; } } while (0)
#define RNN_LOADS(unit_) do { int b_, c_, blk_, row0_; RNN_DECODE(unit_, b_, c_, blk_, row0_); const int tk0_ = 16 * w + 4 * q, gch0_ = blk_ * 64 + 4 * l15; \
        if (MODE != 0) { const bf16_t* gp0 = PROJ + (size_t)(row0_ + tk0_) * NPROJ + COL_GR + gch0_; \
            _Pragma("unroll") for (int r = 0; r < 4; ++r) n_gv[r] = *(const u32x2*)(gp0 + (size_t)r * NPROJ); } \
        if (MODE == 1) { const unsigned* DUp = (const unsigned*)(F.ws + WS_DU) + (size_t)(row0_ + tk0_) * DRNN + gch0_; \
            _Pragma("unroll") for (int r = 0; r < 4; ++r) n_du[r] = *(const u32x4*)(DUp + (size_t)r * DRNN); \
            const float* SUMM = (const float*)(F.ws + WS_SUMM); \
            _Pragma("unroll") for (int kk = 0; kk < 8; ++kk) { const int k = 8 * w + kk, kc = (k < c_) ? k : 0; n_sv[kk] = *(const f32x2*)(SUMM + ((size_t)(b_ * 64 + kc) * 1024 + blk_ * 64 + lane) * 2); } } \
        else { _Pragma("unroll") for (int t = 0; t < 3; ++t) { const int id = lane + 64 * t, i = id >> 3, ch = id & 7; n_vx[t] = (u32x4){0u, 0u, 0u, 0u}; \
                const int cr = 16 * w - 3 + i; const bool ok = (id < 19 * 8) && ((MODE == 2) ? (cr >= 0) : (c_ > 0 || cr >= 0)); \
                if (ok) n_vx[t] = *(const u32x4*)(PROJ + (size_t)(row0_ + cr) * NPROJ + COL_XR + blk_ * 64 + ch * 8); } } } while (0)
    f32x4 cw0 = {0.f, 0.f, 0.f, 0.f}, cw1 = cw0, cw2 = cw0, cw3 = cw0, cbv = cw0, ba4 = cw0, bx4 = cw0, lam4 = cw0;
    if (F.bid < n_units) RNN_LOADS(F.bid);
    for (int unit = F.bid; unit < n_units; unit += F.G, par ^= 1) {
        int b = 0, c = 0, blk, row0;
        RNN_DECODE(unit, b, c, blk, row0);
        LAS float* WT = (LAS float*)(F.lds + R_WT) + par * 1024; LAS float* PART = (LAS float*)(F.lds + R_PART) + par * 1024;
        if (MODE != 1 && blk != cur_blk) {
            if (cur_blk >= 0) LDS_BARRIER();
            const bf16_t* WG = (const bf16_t*)(F.ws + WS_WG) + (size_t)blk * 8192;
#pragma unroll
            for (int t = 0; t < 2; ++t) { const int id = tid + NTHREADS * t, np = id >> 3, ch = id & 7, j = np >> 4, l = np & 15, n = 64 * (j >> 2) + 4 * l + (j & 3);
                *(LAS u32x4*)(WGL + np * 72 + ch * 8) = *(const u32x4*)(WG + n * 64 + ch * 8); }
            { const int g0 = blk * 64 + 4 * l15;
              cw0 = *(const f32x4*)(F.in[9] + g0); cw1 = *(const f32x4*)(F.in[9] + 1024 + g0); cw2 = *(const f32x4*)(F.in[9] + 2048 + g0); cw3 = *(const f32x4*)(F.in[9] + 3072 + g0);
              cbv = *(const f32x4*)(F.in[10] + g0); ba4 = *(const f32x4*)(F.in[12] + g0); bx4 = *(const f32x4*)(F.in[14] + g0); lam4 = *(const f32x4*)(F.in[15] + g0); }
            LDS_BARRIER(); cur_blk = blk;
        }
        const int tk0 = 16 * w + 4 * q, gch0 = blk * 64 + 4 * l15;
        unsigned* DU = (unsigned*)(F.ws + WS_DU) + (size_t)(row0 + tk0) * DRNN + gch0;
        float av[4][4], uv[4][4], P4[4], H4[4];
        u32x4 vx[3], du4[4]; u32x2 gvv[4]; f32x2 sv[8];
#pragma unroll
        for (int r = 0; r < 4; ++r) { gvv[r] = n_gv[r]; du4[r] = n_du[r]; }
#pragma unroll
        for (int t = 0; t < 3; ++t) vx[t] = n_vx[t];
#pragma unroll
        for (int kk = 0; kk < 8; ++kk) sv[kk] = n_sv[kk];
        if (unit + F.G < n_units) RNN_LOADS(unit + F.G);
        if (MODE == 1) {
            float P = 1.f, H = 0.f;
#pragma unroll
            for (int kk = 0; kk < 8; ++kk) { const int k = 8 * w + kk; if (k < c) { H = H * sv[kk].x + sv[kk].y; P = P * sv[kk].x; } }
            PART[(w * 64 + lane) * 2] = P; PART[(w * 64 + lane) * 2 + 1] = H;
#pragma unroll
            for (int jj = 0; jj < 4; ++jj) { float Pj = 1.f, Hj = 0.f;
#pragma unroll
                for (int r = 0; r < 4; ++r) { const float a = 1.0f - bflo(du4[r][jj]), u = bfhi(du4[r][jj]); av[jj][r] = a; uv[jj][r] = u; Hj = Hj * a + u; Pj = Pj * a; }
                P4[jj] = Pj; H4[jj] = Hj; }
        } else {
#pragma unroll
        for (int t = 0; t < 3; ++t) { const int id = lane + 64 * t, i = id >> 3, ch = id & 7;
            if (id < 19 * 8) { *(LAS u32x2*)(XBw + i * 68 + ch * 8) = (u32x2){vx[t].x, vx[t].y}; *(LAS u32x2*)(XBw + i * 68 + ch * 8 + 4) = (u32x2){vx[t].z, vx[t].w}; } }
        LDS_WAIT();
        f32x4 xin[7];
#pragma unroll
        for (int j = 0; j < 7; ++j) { const u32x2 p = *(const LAS u32x2*)(XBw + (4 * q + j) * 68 + 4 * l15); xin[j] = (f32x4){bflo(p.x), bfhi(p.x), bflo(p.y), bfhi(p.y)}; }
        if (MODE == 2) { const int sq = (row0 - MP) / 4 + 4 * w + q;
#pragma unroll
            for (int j = 0; j < 3; ++j) xin[j] = *(const f32x4*)(F.in[2] + ((size_t)sq * 3 + j) * 1024 + gch0); }
        f32x4 xc[4];
#pragma unroll
        for (int r = 0; r < 4; ++r) { xc[r] = cbv + cw0 * xin[r] + cw1 * xin[r + 1] + cw2 * xin[r + 2] + cw3 * xin[r + 3];
            *(LAS u32x2*)(XCBw + (4 * q + r) * 72 + 4 * l15) = (u32x2){pk2(xc[r][0], xc[r][1]), pk2(xc[r][2], xc[r][3])}; }
        LDS_WAIT();
        f32x4 ga[8];
#pragma unroll
        for (int j = 0; j < 8; ++j) ga[j] = (f32x4){0.f, 0.f, 0.f, 0.f};
#pragma unroll
        for (int ks = 0; ks < 2; ++ks) { const bf16x8 af = *(const LAS bf16x8*)(XCBw + l15 * 72 + 32 * ks + 8 * q);
#pragma unroll
            for (int j = 0; j < 8; ++j) { const bf16x8 bfr = *(const LAS bf16x8*)(WGL + (16 * j + l15) * 72 + 32 * ks + 8 * q);
                ga[j] = __builtin_amdgcn_mfma_f32_16x16x32_bf16(af, bfr, ga[j], 0, 0, 0); } }
        u32x4 pw4[4];
#pragma unroll
        for (int jj = 0; jj < 4; ++jj) { const float ba = ba4[jj], bx = bx4[jj], lam = lam4[jj];
            const float c8 = (8.0f * 1.4426950408889634f) * ((lam < -15.f) ? -lam : __logf(1.0f + __expf(-lam)));
            const f32x4 ta = (ga[jj] + ba) * (-1.4426950408889634f), tx = (ga[4 + jj] + bx) * (-1.4426950408889634f);
            f32x4 ea, ex;
#pragma unroll
            for (int r = 0; r < 4; ++r) { ea[r] = __builtin_amdgcn_exp2f(ta[r]); ex[r] = __builtin_amdgcn_exp2f(tx[r]); }
            ea = ea + 1.0f; ex = ex + 1.0f;
            const f32x4 den = ea * ex; f32x4 rc;
#pragma unroll
            for (int r = 0; r < 4; ++r) rc[r] = __builtin_amdgcn_rcpf(den[r]);
            const f32x4 rr = ex * rc, ii = ea * rc, la = rr * (-c8);
            f32x4 a4;
#pragma unroll
            for (int r = 0; r < 4; ++r) a4[r] = __builtin_amdgcn_exp2f(la[r]);
            f32x4 om = 1.0f - a4 * a4, sq;
#pragma unroll
            for (int r = 0; r < 4; ++r) sq[r] = __builtin_amdgcn_sqrtf(fmaxf(om[r], 0.f));
            const f32x4 xcj = {xc[0][jj], xc[1][jj], xc[2][jj], xc[3][jj]};
            f32x4 u4 = sq * (ii * xcj);
            if (MODE == 0) {
#pragma unroll
                for (int r = 0; r < 4; ++r) { const unsigned pw = pk2(1.0f - a4[r], u4[r]); pw4[r][jj] = pw; a4[r] = 1.0f - bflo(pw); u4[r] = bfhi(pw); } }
            float P = 1.f, H = 0.f;
#pragma unroll
            for (int r = 0; r < 4; ++r) { av[jj][r] = a4[r]; uv[jj][r] = u4[r]; H = H * a4[r] + u4[r]; P = P * a4[r]; }
            P4[jj] = P; H4[jj] = H; }
        if (MODE == 0) {
#pragma unroll
            for (int r = 0; r < 4; ++r) *(u32x4*)(DU + (size_t)r * DRNN) = pw4[r]; }
        }
        LAS bf16_t* YBw = XBw;
        if (MODE == 2) {
            const int sq = (row0 - MP) / 4 + 4 * w + q;
            const f32x4 h0 = *(const f32x4*)(F.in[3] + (size_t)sq * 1024 + gch0);
            float ssq[4] = {0.f, 0.f, 0.f, 0.f}; f32x4 hfin; float yv[4][4];
#pragma unroll
            for (int jj = 0; jj < 4; ++jj) { float h = h0[jj];
#pragma unroll
                for (int r = 0; r < 4; ++r) { h = av[jj][r] * h + uv[jj][r];
                    const float g = (jj & 1) ? bfhi(jj < 2 ? gvv[r].x : gvv[r].y) : bflo(jj < 2 ? gvv[r].x : gvv[r].y);
                    const float y = gelu_tanh(g) * h; yv[r][jj] = y; ssq[r] += y * y; }
                hfin[jj] = h; }
            *(f32x4*)(F.out + O_S_RH + (size_t)sq * 1024 + gch0) = hfin;
#pragma unroll
            for (int r = 0; r < 4; ++r) { *(LAS u32x2*)(YBw + (4 * q + r) * 68 + 4 * l15) = (u32x2){pk2(yv[r][0], yv[r][1]), pk2(yv[r][2], yv[r][3])};
                float s = ssq[r]; s += __shfl_xor(s, 1); s += __shfl_xor(s, 2); s += __shfl_xor(s, 4); s += __shfl_xor(s, 8);
                if (l15 == 0) atomicAdd((float*)(F.ws + CT_SS_RNN) + row0 + tk0 + r, s); }
        } else {
            float E_P[4], E_H[4], T_P[4], T_H[4];
#pragma unroll
            for (int jj = 0; jj < 4; ++jj) { float eP = 1.f, eH = 0.f, tP = 1.f, tH = 0.f;
#pragma unroll
                for (int g = 0; g < 4; ++g) { const float pg = __shfl(P4[jj], l15 + 16 * g), hg = __shfl(H4[jj], l15 + 16 * g);
                    if (g < q) { eH = eH * pg + hg; eP = eP * pg; }
                    tH = tH * pg + hg; tP = tP * pg; }
                E_P[jj] = eP; E_H[jj] = eH; T_P[jj] = tP; T_H[jj] = tH; }
            if (q == 0) { LAS float* wt = WT + (w * 64 + 4 * l15) * 2;
                *(LAS f32x4*)wt = (f32x4){T_P[0], T_H[0], T_P[1], T_H[1]}; *(LAS f32x4*)(wt + 4) = (f32x4){T_P[2], T_H[2], T_P[3], T_H[3]}; }
            LDS_BARRIER();
            if (MODE == 0) {
                if (tid < 64) { float P = 1.f, H = 0.f;
#pragma unroll
                    for (int p = 0; p < 8; ++p) { const float pp = WT[(p * 64 + tid) * 2], hh = WT[(p * 64 + tid) * 2 + 1]; H = H * pp + hh; P = P * pp; }
                    float* SUMM = (float*)(F.ws + WS_SUMM); *(f32x2*)(SUMM + ((size_t)(b * 64 + c) * 1024 + blk * 64 + tid) * 2) = (f32x2){P, H}; }
            } else {
                { float h = 0.f; float pp[8], ph[8], wp[7], wh[7];
#pragma unroll
                  for (int p = 0; p < 8; ++p) { pp[p] = PART[(p * 64 + lane) * 2]; ph[p] = PART[(p * 64 + lane) * 2 + 1]; }
#pragma unroll
                  for (int p = 0; p < 7; ++p) { wp[p] = WT[(p * 64 + lane) * 2]; wh[p] = WT[(p * 64 + lane) * 2 + 1]; }
#pragma unroll
                  for (int p = 0; p < 8; ++p) h = h * pp[p] + ph[p];
#pragma unroll
                  for (int p = 0; p < 7; ++p) if (p < w) h = h * wp[p] + wh[p];
                  HINw[lane] = h; }
                LDS_WAIT();
                const f32x4 hin = *(const LAS f32x4*)(HINw + 4 * l15);
                float ssq[4] = {0.f, 0.f, 0.f, 0.f}; f32x4 hfin; float yv[4][4];
#pragma unroll
                for (int jj = 0; jj < 4; ++jj) { float h = hin[jj] * E_P[jj] + E_H[jj];
#pragma unroll
                    for (int r = 0; r < 4; ++r) { h = av[jj][r] * h + uv[jj][r];
                        const float g = (jj & 1) ? bfhi(jj < 2 ? gvv[r].x : gvv[r].y) : bflo(jj < 2 ? gvv[r].x : gvv[r].y);
                        const float y = gelu_tanh(g) * h; yv[r][jj] = y; ssq[r] += y * y; }
                    hfin[jj] = h; }
                if (c == 63 && w == 7 && q == 3) *(f32x4*)(F.out + O_P_RH + (size_t)b * 1024 + gch0) = hfin;
#pragma unroll
                for (int r = 0; r < 4; ++r) { *(LAS u32x2*)(YBw + (4 * q + r) * 68 + 4 * l15) = (u32x2){pk2(yv[r][0], yv[r][1]), pk2(yv[r][2], yv[r][3])};
                    float s = ssq[r]; s += __shfl_xor(s, 1); s += __shfl_xor(s, 2); s += __shfl_xor(s, 4); s += __shfl_xor(s, 8);
                    if (l15 == 0) atomicAdd((float*)(F.ws + CT_SS_RNN) + row0 + tk0 + r, s); }
            }
        }
        if (MODE != 0) {
            LDS_WAIT();
#pragma unroll
            for (int t = 0; t < 2; ++t) { const int id = lane + 64 * t, i = id >> 3, ch = id & 7;
                const u32x2 a = *(const LAS u32x2*)(YBw + i * 68 + ch * 8), b2 = *(const LAS u32x2*)(YBw + i * 68 + ch * 8 + 4);
                *(u32x4*)((bf16_t*)(F.ws + WS_MERGED) + (size_t)(row0 + 16 * w + i) * DM + blk * 64 + ch * 8) = (u32x4){a.x, a.y, b2.x, b2.y}; }
            LDS_WAIT();
        }
    }
}

#undef RNN_LOADS
#undef RNN_DECODE
__device__ __forceinline__ int t5_bucket(int n) {
    if (n < 16) return n;
    int l = 16 + (int)(__logf((float)n * (1.0f / 16.0f)) * (16.0f / 2.0794415416798357f));
    return l < 31 ? l : 31;
}
constexpr int A_KL = 0, A_VT = 36864, A_BIAS = 70656, A_END = 81152;
__device__ __forceinline__ void attn_prompt_unit(const Ctx& F, int unit, bool first) {
    const bf16_t* PROJ = (const bf16_t*)(F.ws + WS_PROJ);
    const int tid = F.tid, lane = F.lane, w = F.wave, l15 = lane & 15, q = lane >> 4;
    const int kvh = unit & 3, qb = (unit >> 2) & 63, b = unit >> 8;
    LAS bf16_t* KL = (LAS bf16_t*)(F.lds + A_KL); LAS bf16_t* VT = (LAS bf16_t*)(F.lds + A_VT); LAS float* BIAS = (LAS float*)(F.lds + A_BIAS);
    LAS float* TB = (LAS float*)(F.lds + A_END);
    LDS_BARRIER();
    float tbv = 0.f;
    if (first && tid < 128) tbv = F.in[17][(tid >> 2) * 16 + 4 * kvh + (tid & 3)] * 1.4426950408889634f;
    const int kb0 = qb * 128 - 128;
#pragma unroll
    for (int i = 0; i < 4; ++i) { const int id = tid + NTHREADS * i, r = id >> 3, ch = id & 7; const int t = kb0 + r;
        u32x4 v = {0u, 0u, 0u, 0u};
        if (t >= 0) v = *(const u32x4*)(PROJ + (size_t)(b * SEQ + t) * NPROJ + COL_K + kvh * 64 + ch * 8);
        *(LAS u32x4*)(KL + r * 72 + ch * 8) = v; }
#pragma unroll
    for (int i = 0; i < 4; ++i) { const int id = tid + NTHREADS * i, key = id & 255, ch = id >> 8; const int t = kb0 + key;
        u32x4 v = {0u, 0u, 0u, 0u};
        if (t >= 0) v = *(const u32x4*)(PROJ + (size_t)(b * SEQ + t) * NPROJ + COL_V + kvh * 64 + ch * 8);
        LAS bf16_t* d = VT + (ch * 8) * 264 + key;
        d[0 * 264] = (bf16_t)(v.x & 0xffffu); d[1 * 264] = (bf16_t)(v.x >> 16); d[2 * 264] = (bf16_t)(v.y & 0xffffu); d[3 * 264] = (bf16_t)(v.y >> 16);
        d[4 * 264] = (bf16_t)(v.z & 0xffffu); d[5 * 264] = (bf16_t)(v.z >> 16); d[6 * 264] = (bf16_t)(v.w & 0xffffu); d[7 * 264] = (bf16_t)(v.w >> 16); }
    if (first) {
        if (tid < 128) TB[tid] = tbv;
        LDS_BARRIER();
        for (int id = tid; id < 4 * 4 * 164; id += NTHREADS) { const int cp = id / 656, g = (id / 164) & 3, k = id % 164, d = 144 + cp - k;
            BIAS[id] = (d >= 0 && d < 128) ? TB[t5_bucket(d) * 4 + g] : -1e30f; } }
    LDS_BARRIER();
    const int i_q = 16 * w + l15;
    const int qrow = b * SEQ + qb * 128 + i_q;
    bf16x8 qfa[4][2];
#pragma unroll
    for (int g = 0; g < 4; ++g) { qfa[g][0] = *(const bf16x8*)(PROJ + (size_t)qrow * NPROJ + COL_Q + (4 * kvh + g) * 64 + 8 * q); qfa[g][1] = *(const bf16x8*)(PROJ + (size_t)qrow * NPROJ + COL_Q + (4 * kvh + g) * 64 + 32 + 8 * q); }
#pragma unroll
    for (int g = 0; g < 4; ++g) {
        const int head = 4 * kvh + g;
        const bf16x8 qf0 = qfa[g][0], qf1 = qfa[g][1];
        f32x4 sc[10];
#pragma unroll
        for (int jj = 0; jj < 9; ++jj) { const int j = w + jj; sc[jj] = (f32x4){0.f, 0.f, 0.f, 0.f};
            const bf16x8 k0 = *(const LAS bf16x8*)(KL + (16 * j + l15) * 72 + 8 * q), k1 = *(const LAS bf16x8*)(KL + (16 * j + l15) * 72 + 32 + 8 * q);
            sc[jj] = __builtin_amdgcn_mfma_f32_16x16x32_bf16(k0, qf0, sc[jj], 0, 0, 0); sc[jj] = __builtin_amdgcn_mfma_f32_16x16x32_bf16(k1, qf1, sc[jj], 0, 0, 0);
            if (jj & 1) asm volatile("" ::: "memory"); }
        sc[9] = (f32x4){0.f, 0.f, 0.f, 0.f};
        const float sink = F.in[16][head] * 1.4426950408889634f;
        const LAS float* bt = BIAS + ((l15 & 3) * 4 + g) * 164 + (144 + (l15 & 3) - (128 + i_q - 16 * w - 4 * q));
        float mx = sink;
#pragma unroll
        for (int jj = 0; jj < 9; ++jj) { f32x4 s4 = sc[jj] * (0.125f * 1.4426950408889634f) + *(const LAS f32x4*)(bt + 16 * jj);
            if (qb == 0) {
#pragma unroll
                for (int r = 0; r < 4; ++r) { const int jk = 16 * (w + jj) + 4 * q + r; s4[r] = (jk >= 128) ? s4[r] : -1e30f; } }
            sc[jj] = s4; mx = fmaxf(fmaxf(mx, fmaxf(s4[0], s4[1])), fmaxf(s4[2], s4[3])); }
        mx = fmaxf(mx, __shfl_xor(mx, 16)); mx = fmaxf(mx, __shfl_xor(mx, 32));
        f32x4 l4 = {0.f, 0.f, 0.f, 0.f};
#pragma unroll
        for (int jj = 0; jj < 9; ++jj) { const f32x4 d4 = sc[jj] - mx; f32x4 p4;
            p4[0] = __builtin_amdgcn_exp2f(d4[0]); p4[1] = __builtin_amdgcn_exp2f(d4[1]); p4[2] = __builtin_amdgcn_exp2f(d4[2]); p4[3] = __builtin_amdgcn_exp2f(d4[3]);
            sc[jj] = p4; l4 = l4 + p4; }
        float l = (l4[0] + l4[1]) + (l4[2] + l4[3]);
        l += __shfl_xor(l, 16); l += __shfl_xor(l, 32);
        const float inv = __builtin_amdgcn_rcpf(l + __builtin_amdgcn_exp2f(sink - mx));
        f32x4 o[4];
#pragma unroll
        for (int dt = 0; dt < 4; ++dt) o[dt] = (f32x4){0.f, 0.f, 0.f, 0.f};
#pragma unroll
        for (int pp = 0; pp < 5; ++pp) {
            u32x4 pw; pw.x = pk2(sc[2 * pp][0], sc[2 * pp][1]); pw.y = pk2(sc[2 * pp][2], sc[2 * pp][3]); pw.z = pk2(sc[2 * pp + 1][0], sc[2 * pp + 1][1]); pw.w = pk2(sc[2 * pp + 1][2], sc[2 * pp + 1][3]);
            const bf16x8 pf = __builtin_bit_cast(bf16x8, pw);
            const int j0 = w + 2 * pp; int j1 = j0 + 1; if (j1 > 15) j1 = 15;
#pragma unroll
            for (int dt = 0; dt < 4; ++dt) { const LAS bf16_t* vr = VT + (16 * dt + l15) * 264;
                const u32x2 a0 = *(const LAS u32x2*)(vr + 16 * j0 + 4 * q), a1 = *(const LAS u32x2*)(vr + 16 * j1 + 4 * q);
                const bf16x8 vf = __builtin_bit_cast(bf16x8, (u32x4){a0.x, a0.y, a1.x, a1.y});
                o[dt] = __builtin_amdgcn_mfma_f32_16x16x32_bf16(vf, pf, o[dt], 0, 0, 0); }
            asm volatile("" ::: "memory"); }
        float ssq = 0.f;
        bf16_t* yo = (bf16_t*)(F.ws + WS_MERGED) + (size_t)qrow * DM + DRNN + head * 64 + 4 * q;
#pragma unroll
        for (int dt = 0; dt < 4; ++dt) { const f32x4 v = o[dt] * inv; ssq += (v[0] * v[0] + v[1] * v[1]) + (v[2] * v[2] + v[3] * v[3]);
            u32x2 wv; wv.x = pk2(v[0], v[1]); wv.y = pk2(v[2], v[3]); *(u32x2*)(yo + 16 * dt) = wv; }
        ssq += __shfl_xor(ssq, 16); ssq += __shfl_xor(ssq, 32);
        if (q == 0) atomicAdd((float*)(F.ws + CT_SS_ATT) + qrow, ssq);
    }
}
constexpr int AS_PW = 0, AS_BIAS = 24576, AS_RED = 45056, AS_TB = 77824;
__device__ __forceinline__ void attn_sample_unit(const Ctx& F, int unit) {
    const bf16_t* PROJ = (const bf16_t*)(F.ws + WS_PROJ);
    const int lane = F.lane, w = F.wave, l15 = lane & 15, q = lane >> 4;
    const int task = w >> 2, part = w & 3;
    const int wu = unit * 2 + task, s = wu >> 2, kvh = wu & 3;
    LAS float* PW = (LAS float*)(F.lds + AS_PW + w * 3072);
    LAS float* RED = (LAS float*)(F.lds + AS_RED + task * 16384);
    LDS_BARRIER();
    const int g = l15 >> 2, qi = l15 & 3, head = 4 * kvh + g;
    const size_t qrow = (size_t)(MP + 4 * s + qi);
    const bf16x8 qf0 = *(const bf16x8*)(PROJ + qrow * NPROJ + COL_Q + head * 64 + 8 * q);
    const bf16x8 qf1 = *(const bf16x8*)(PROJ + qrow * NPROJ + COL_Q + head * 64 + 32 + 8 * q);
    const float tb0 = F.in[17][(lane >> 2) * 16 + 4 * kvh + (lane & 3)], tb1 = F.in[17][(16 + (lane >> 2)) * 16 + 4 * kvh + (lane & 3)];
    f32x4 sc[9];
#pragma unroll
    for (int j = 0; j < 8; ++j) { const int kk = 16 * j + l15; sc[j] = (f32x4){0.f, 0.f, 0.f, 0.f};
        const float* kp = F.in[4] + ((size_t)(s * 128 + kk) * 4 + kvh) * 64 + 8 * q;
        const f32x4 a = *(const f32x4*)kp, bq = *(const f32x4*)(kp + 4), cq = *(const f32x4*)(kp + 32), dq = *(const f32x4*)(kp + 36);
        const bf16x8 k0 = __builtin_bit_cast(bf16x8, (u32x4){pk2(a[0], a[1]), pk2(a[2], a[3]), pk2(bq[0], bq[1]), pk2(bq[2], bq[3])});
        const bf16x8 k1 = __builtin_bit_cast(bf16x8, (u32x4){pk2(cq[0], cq[1]), pk2(cq[2], cq[3]), pk2(dq[0], dq[1]), pk2(dq[2], dq[3])});
        sc[j] = __builtin_amdgcn_mfma_f32_16x16x32_bf16(k0, qf0, sc[j], 0, 0, 0); sc[j] = __builtin_amdgcn_mfma_f32_16x16x32_bf16(k1, qf1, sc[j], 0, 0, 0);
        if (j % 4 == 3) asm volatile("" ::: "memory"); }
    {
        const bf16_t* kp = PROJ + (size_t)(MP + 4 * s + (l15 & 3)) * NPROJ + COL_K + kvh * 64 + 8 * q;
        u32x4 a = *(const u32x4*)kp, b2 = *(const u32x4*)(kp + 32);
        if (l15 >= 4) { a = (u32x4){0u, 0u, 0u, 0u}; b2 = a; }
        sc[8] = (f32x4){0.f, 0.f, 0.f, 0.f};
        sc[8] = __builtin_amdgcn_mfma_f32_16x16x32_bf16(__builtin_bit_cast(bf16x8, a), qf0, sc[8], 0, 0, 0); sc[8] = __builtin_amdgcn_mfma_f32_16x16x32_bf16(__builtin_bit_cast(bf16x8, b2), qf1, sc[8], 0, 0, 0); }
    const float sink = F.in[16][head] * 1.4426950408889634f;
    LAS float* BT = (LAS float*)(F.lds + AS_BIAS + w * 2560); LAS float* TB = (LAS float*)(F.lds + AS_TB + w * 512);
    TB[lane] = tb0 * 1.4426950408889634f; TB[64 + lane] = tb1 * 1.4426950408889634f;
    LDS_WAIT(); asm volatile("" ::: "memory");
    for (int id = lane; id < 640; id += 64) { const int gg = id / 160, d = id % 160 - 16; BT[id] = (d >= 0 && d < 128) ? TB[t5_bucket(d) * 4 + gg] : -1e30f; }
    LDS_WAIT(); asm volatile("" ::: "memory");
    float mx = sink;
#pragma unroll
    for (int j = 0; j < 9; ++j)
#pragma unroll
        for (int r = 0; r < 4; ++r) { const int key = 16 * j + 4 * q + r, dist = 128 + qi - key;
            const float sv = sc[j][r] * (0.125f * 1.4426950408889634f) + BT[g * 160 + dist + 16]; sc[j][r] = sv; mx = fmaxf(mx, sv); }
    mx = fmaxf(mx, __shfl_xor(mx, 16)); mx = fmaxf(mx, __shfl_xor(mx, 32));
    float l = 0.f;
#pragma unroll
    for (int j = 0; j < 9; ++j)
#pragma unroll
        for (int r = 0; r < 4; ++r) { const float p = __builtin_amdgcn_exp2f(sc[j][r] - mx); sc[j][r] = p; l += p; }
    l += __shfl_xor(l, 16); l += __shfl_xor(l, 32);
    const float inv = __builtin_amdgcn_rcpf(l + __builtin_amdgcn_exp2f(sink - mx));
#pragma unroll
    for (int j = 0; j < 8; ++j)
        if ((j >> 1) == part) {
#pragma unroll
            for (int r = 0; r < 4; ++r) PW[(16 * (j & 1) + 4 * q + r) * 16 + l15] = sc[j][r] * inv; }
    if (part == 3) {
#pragma unroll
        for (int r = 0; r < 4; ++r) PW[(32 + 4 * q + r) * 16 + l15] = sc[8][r] * inv; }
    LDS_WAIT(); asm volatile("" ::: "memory");
    float o[16];
#pragma unroll
    for (int i = 0; i < 16; ++i) o[i] = 0.f;
#pragma unroll 1
    for (int kb = 0; kb < 2; ++kb) { float vv[16];
#pragma unroll
      for (int j = 0; j < 16; ++j) vv[j] = F.in[5][((size_t)(s * 128 + 32 * part + 16 * kb + j) * 4 + kvh) * 64 + lane];
#pragma unroll
      for (int j = 0; j < 16; ++j) { const float v = vv[j]; const int key = 16 * kb + j;
          const f32x4 p0 = *(const LAS f32x4*)(PW + key * 16), p1 = *(const LAS f32x4*)(PW + key * 16 + 4), p2 = *(const LAS f32x4*)(PW + key * 16 + 8), p3 = *(const LAS f32x4*)(PW + key * 16 + 12);
#pragma unroll
          for (int e = 0; e < 4; ++e) { o[e] += p0[e] * v; o[4 + e] += p1[e] * v; o[8 + e] += p2[e] * v; o[12 + e] += p3[e] * v; } } }
    if (part == 3) { float vn[4];
#pragma unroll
      for (int j = 0; j < 4; ++j) vn[j] = bf2f(PROJ[(size_t)(MP + 4 * s + j) * NPROJ + COL_V + kvh * 64 + lane]);
#pragma unroll
      for (int j = 0; j < 4; ++j) { const int key = 32 + j; const float v = vn[j];
          const f32x4 p0 = *(const LAS f32x4*)(PW + key * 16), p1 = *(const LAS f32x4*)(PW + key * 16 + 4), p2 = *(const LAS f32x4*)(PW + key * 16 + 8), p3 = *(const LAS f32x4*)(PW + key * 16 + 12);
#pragma unroll
          for (int e = 0; e < 4; ++e) { o[e] += p0[e] * v; o[4 + e] += p1[e] * v; o[8 + e] += p2[e] * v; o[12 + e] += p3[e] * v; } } }
#pragma unroll
    for (int i = 0; i < 16; ++i) RED[(part * 16 + i) * 64 + lane] = o[i];
    LDS_BARRIER();
#pragma unroll
    for (int qq = 0; qq < 4; ++qq) { const int i = part * 4 + qq;
        const float t = (RED[(0 * 16 + i) * 64 + lane] + RED[(1 * 16 + i) * 64 + lane]) + (RED[(2 * 16 + i) * 64 + lane] + RED[(3 * 16 + i) * 64 + lane]);
        ((bf16_t*)(F.ws + WS_MERGED))[(size_t)(MP + 4 * s + qq) * DM + DRNN + (4 * kvh + part) * 64 + lane] = (bf16_t)(pk2(t, 0.f) & 0xffffu);
        const float t2 = wave_sum(t * t); if (lane == 0) atomicAdd((float*)(F.ws + CT_SS_ATT) + MP + 4 * s + qq, t2); }
}

__device__ __forceinline__ void p7_final(const Ctx& F) {
    const float* g = F.in[26]; const float* slab = (const float*)(F.ws + WS_SLAB); const bf16_t* HB = (const bf16_t*)(F.ws + WS_XN); LAS float* red = (LAS float*)F.lds;
    for (int m0 = 2 * F.bid; m0 < MS; m0 += 2 * F.G) { const int m = m0 + (F.wave >> 2), qd = F.wave & 3; float* yr = F.out + (size_t)(MP + m) * DM;
        f32x4 v[2], gg7[2];
#pragma unroll
        for (int j = 0; j < 2; ++j) { v[j] = ld_bf4(HB + (size_t)(MP + m) * DM + 512 * qd + 4 * (F.lane + 64 * j)); gg7[j] = *(const f32x4*)(g + 512 * qd + 4 * (F.lane + 64 * j)); }
#pragma unroll
        for (int sp0 = 0; sp0 < 16; sp0 += 8) { f32x4 t[8][2];
#pragma unroll
            for (int sp = 0; sp < 8; ++sp)
#pragma unroll
                for (int j = 0; j < 2; ++j) t[sp][j] = *(const f32x4*)(slab + ((size_t)(sp0 + sp) * MS + m) * DM + 512 * qd + 4 * (F.lane + 64 * j));
#pragma unroll
            for (int j = 0; j < 2; ++j) v[j] = v[j] + (((t[0][j] + t[1][j]) + (t[2][j] + t[3][j])) + ((t[4][j] + t[5][j]) + (t[6][j] + t[7][j]))); }
        float s = 0.f;
#pragma unroll
        for (int j = 0; j < 2; ++j) s += (v[j][0] * v[j][0] + v[j][1] * v[j][1]) + (v[j][2] * v[j][2] + v[j][3] * v[j][3]);
        s = wave_sum(s);
        LDS_BARRIER();
        if (F.lane == 0) red[F.wave] = s;
        LDS_BARRIER();
        const int w0 = F.wave & 4; const float rstd = __builtin_amdgcn_rsqf(((red[w0] + red[w0 + 1]) + (red[w0 + 2] + red[w0 + 3])) * (1.0f / DM) + EPS);
#pragma unroll
        for (int j = 0; j < 2; ++j) { const int cidx = 512 * qd + 4 * (F.lane + 64 * j); *(f32x4*)(yr + cidx) = v[j] * rstd * gg7[j]; } }
}

__global__ void __launch_bounds__(NTHREADS, 2) hymba_fwd(Args args) {
    extern __shared__ __attribute__((aligned(16))) unsigned char lds_raw[];
    Ctx F; F.lds = (LAS unsigned char*)lds_raw; F.tid = threadIdx.x; F.lane = F.tid & 63; F.wave = __builtin_amdgcn_readfirstlane(F.tid >> 6);
    F.bid = blockIdx.x; F.G = gridDim.x; F.in = args.in; F.out = args.out; F.ws = args.ws;
    const int lo = args.ph_lo, hi = args.ph_hi;
    XcdBarrier bar; bar.bar = (unsigned*)(F.ws + CT_BAR); bar.x = 0; bar.st = (volatile LAS unsigned*)(F.lds + LDS_MISC);
    if (MK_N_LAUNCHES == 1) { if (F.tid < 64) ((LAS unsigned*)(F.lds + LDS_MISC))[F.tid] = 0u; __syncthreads(); bar = xcd_barrier_post((unsigned*)(F.ws + CT_BAR), (volatile LAS unsigned*)(F.lds + LDS_MISC)); }
#define IN(k) (lo <= (k) && (k) < hi)
#define RELAUNDER() do { int t_ = threadIdx.x; asm volatile("" : "+v"(t_)); F.tid = t_; F.lane = t_ & 63; } while (0)
#define GRIDBAR() do { if (MK_N_LAUNCHES == 1) xcd_barrier(bar); } while (0)
#define SEAM(k) do { if (IN(k) && IN((k) + 1)) { GRIDBAR(); } } while (0)
    bf16_t* XN = (bf16_t*)(F.ws + WS_XN); bf16_t* PROJ = (bf16_t*)(F.ws + WS_PROJ); bf16_t* MERGED = (bf16_t*)(F.ws + WS_MERGED); bf16_t* ACT = (bf16_t*)(F.ws + WS_ACT);
    float* SS_RNN = (float*)(F.ws + CT_SS_RNN); float* SS_ATT = (float*)(F.ws + CT_SS_ATT); float* SS_H = (float*)(F.ws + CT_SS_H);

    if (IN(0)) { RELAUNDER(); p0_prologue(F); }
    SEAM(0);
    if (IN(1)) { RELAUNDER(); gm::Order<0> S; S.init(MT / 256, NPROJ / 256, F.G, F.bid); gm::EpiProj E{PROJ, NPROJ, (const float*)(F.ws + CT_RSTD_X), (LAS float*)(F.lds + gm::STAGE_BYTES)};
        gm::gemm_phase(F.lds, XN, (const bf16_t*)(F.ws + WS_WIN), DM, DM / 64, S, E);
        { const int nfull = (MT / 256) * (NPROJ / 256) - 3 * F.G;
          if (F.G == 256 && F.bid >= nfull) convert_weights(F, 2 | 4, F.bid - nfull, F.G - nfull);
          else if (F.G != 256) convert_weights(F, 2 | 4, F.bid, F.G); } }
    SEAM(1);
    if (IN(2)) { RELAUNDER();
        rnn_phase<0>(F, 2048);
        if (MK_N_LAUNCHES == 1) split_arrive((unsigned*)(F.ws + CT_BAR2));
        for (int u = F.bid; u < 512; u += F.G) attn_prompt_unit(F, u, u == F.bid || (F.G & 3) != 0);
        for (int u = F.bid; u < 256; u += F.G) attn_sample_unit(F, u);
        if (F.G == 256) { if (F.bid < 64) rnn_phase<2>(F, 64); else p2_copies(F, F.bid - 64, F.G - 64); }
        else p2_copies(F, F.bid, F.G);
    }
    if (MK_N_LAUNCHES != 1) SEAM(2);
    if (IN(3)) { RELAUNDER();
        if (MK_N_LAUNCHES == 1) split_wait((unsigned*)(F.ws + CT_BAR2), (unsigned*)(F.ws + CT_BAR) + XB_TMO);
        rnn_phase<1>(F, 2048);
        if (F.G != 256) rnn_phase<2>(F, 64);
    }
    SEAM(3);
    if (IN(4)) { RELAUNDER();
        if (F.G != 256) convert_weights(F, 8, F.bid, F.G);
        __syncthreads();
        { gm::SplitOrder S; S.init(8, 256, F.G, F.bid); gm::EpiSlab<true> E{(float*)(F.ws + WS_SLAB), 256, SS_RNN, SS_ATT, (LAS float*)(F.lds + gm::STAGE_BYTES)};
          gm::gemm_phase(F.lds, MERGED, (const bf16_t*)(F.ws + WS_WOUT), DM, 4, S, E); }
        if (MK_N_LAUNCHES == 1 && F.G == 256 && F.bid < 128) split_arrive((unsigned*)(F.ws + CT_BAR3));
        { gm::Order<0> S; S.init(MP / 256, DM / 256, F.G, F.bid); gm::EpiH E{F.in[0], F.in[1], XN, SS_RNN, SS_ATT, SS_H, (LAS float*)(F.lds + gm::STAGE_BYTES)};
          gm::gemm_phase(F.lds, MERGED, (const bf16_t*)(F.ws + WS_WOUT), DM, DM / 64, S, E); }
        const bool fast4 = (MK_N_LAUNCHES == 1 && F.G == 256);
        int cpart = F.bid, cnparts = F.G; bool do_combine = true;
        if (fast4) { do_combine = F.bid >= 128; cpart = F.bid - 128; cnparts = 128;
            if (do_combine) split_wait((unsigned*)(F.ws + CT_BAR3), (unsigned*)(F.ws + CT_BAR) + XB_TMO, 128u); }
        else GRIDBAR();
        if (do_combine) { const float* slab = (const float*)(F.ws + WS_SLAB); LAS float* red = (LAS float*)F.lds;
          for (int m0 = 2 * cpart; m0 < MS; m0 += 2 * cnparts) { const int m = m0 + (F.wave >> 2), qd = F.wave & 3;
            f32x4 v[2], t[8][2];
#pragma unroll
            for (int j = 0; j < 2; ++j) { const int cidx = 512 * qd + 4 * (F.lane + 64 * j); v[j] = *(const f32x4*)(F.in[1] + (size_t)m * DM + cidx);
#pragma unroll
                for (int sp = 0; sp < 8; ++sp) t[sp][j] = *(const f32x4*)(slab + ((size_t)sp * MS + m) * DM + cidx); }
            float s = 0.f;
#pragma unroll
            for (int j = 0; j < 2; ++j) { const int cidx = 512 * qd + 4 * (F.lane + 64 * j);
                v[j] = v[j] + (((t[0][j] + t[1][j]) + (t[2][j] + t[3][j])) + ((t[4][j] + t[5][j]) + (t[6][j] + t[7][j])));
                u32x2 w; w.x = pk2(v[j][0], v[j][1]); w.y = pk2(v[j][2], v[j][3]); *(u32x2*)(XN + (size_t)(MP + m) * DM + cidx) = w;
                s += (v[j][0] * v[j][0] + v[j][1] * v[j][1]) + (v[j][2] * v[j][2] + v[j][3] * v[j][3]); }
            s = wave_sum(s);
            LDS_BARRIER();
            if (F.lane == 0) red[F.wave] = s;
            LDS_BARRIER();
            if (qd == 0 && F.lane == 0) SS_H[MP + m] = (red[F.wave] + red[F.wave + 1]) + (red[F.wave + 2] + red[F.wave + 3]); } }
        if (fast4) GRIDBAR();
        else if (MK_N_LAUNCHES == 1) split_arrive((unsigned*)(F.ws + CT_BAR3));
    }
    if (MK_N_LAUNCHES != 1) SEAM(4);
    if (IN(5)) { RELAUNDER();
        {
            { gm::Order<1> S; S.init(66, NUP / 256, F.G, F.bid); gm::EpiAct<false> E{ACT, SS_H, F.in[23], F.in[24], F.in[6], F.out + O_P_FFN, F.out + O_S_FFN, F.ws, (LAS float*)(F.lds + gm::STAGE_BYTES)};
              gm::gemm_phase(F.lds, XN, (const bf16_t*)(F.ws + WS_WUP), DM, DM / 64, S, E); }
            if (MK_N_LAUNCHES == 1 && F.G != 256) split_wait((unsigned*)(F.ws + CT_BAR3), (unsigned*)(F.ws + CT_BAR) + XB_TMO);
            { gm::Order<2> S; S.init(2, NUP / 256, F.G, (F.bid + F.G - 96 % F.G) % F.G); gm::EpiAct<true> E{ACT, SS_H, F.in[23], F.in[24], F.in[6], F.out + O_P_FFN, F.out + O_S_FFN, F.ws, (LAS float*)(F.lds + gm::STAGE_BYTES)};
              gm::gemm_phase(F.lds, XN, (const bf16_t*)(F.ws + WS_WUP), DM, DM / 64, S, E); }
        }
        if (F.G == 256 && F.bid >= 192) convert_weights(F, 8 | 16, F.bid - 192, 64);
        else if (F.G != 256) convert_weights(F, 16, F.bid, F.G);
    }
    SEAM(5);
    if (IN(6)) { RELAUNDER();
        { gm::Order<3> S; S.init(MP / 256, DM / 256, F.G, F.bid);
          gm::EpiOutNorm E{XN, F.out, F.in[26], (float*)(F.ws + WS_XCH), (unsigned*)(F.ws + CT_PCNT), (unsigned*)(F.ws + CT_BAR) + XB_TMO, (LAS float*)(F.lds + gm::STAGE_BYTES)};
          gm::gemm_phase(F.lds, ACT, (const bf16_t*)(F.ws + WS_WDOWN), DFF, DFF / 64, S, E); }
        { gm::SplitOrder S; S.init(16, 384, F.G, F.bid); gm::EpiSlab<false> E{(float*)(F.ws + WS_SLAB), 384, nullptr, nullptr, (LAS float*)(F.lds + gm::STAGE_BYTES)};
          gm::gemm_phase(F.lds, ACT, (const bf16_t*)(F.ws + WS_WDOWN), DFF, 6, S, E); }
    }
    SEAM(6);
    if (IN(7)) { RELAUNDER(); p7_final(F); }
#undef IN
#undef SEAM
}

extern "C" void kernel_launch(void* const* d_in, const int* in_sizes, int n_in, void* d_out, int out_size, void* d_ws, size_t ws_size, hipStream_t stream) {
    static int grid = 0;
    if (grid == 0) {
        if (n_in != 27 || out_size != (int)O_END || ws_size < WS_END) { fprintf(stderr, "kernel_launch: unexpected shapes (n_in %d out %d ws %zu)\n", n_in, out_size, ws_size); grid = -1; return; }
        int dev = 0, cus = 0, per_cu = 0;
        hipGetDevice(&dev); hipDeviceGetAttribute(&cus, hipDeviceAttributeMultiprocessorCount, dev);
        hipFuncSetAttribute((const void*)hymba_fwd, hipFuncAttributeMaxDynamicSharedMemorySize, LDS_BYTES);
        hipOccupancyMaxActiveBlocksPerMultiprocessor(&per_cu, (const void*)hymba_fwd, NTHREADS, LDS_BYTES);
        if (per_cu < 1) { fprintf(stderr, "kernel_launch: occupancy query says %d blocks per CU\n", per_cu); per_cu = 1; }
        (void)hipGetLastError();
        grid = cus;
    }
    if (grid < 0) return;
    hipMemsetAsync((char*)d_ws + WS_CTL, 0, CTL_BYTES, stream);
    Args a{};
    for (int i = 0; i < 27; ++i) a.in[i] = (const float*)d_in[i];
    a.out = (float*)d_out; a.ws = (unsigned char*)d_ws;
    if (MK_N_LAUNCHES == 1) {
        a.ph_lo = 0; a.ph_hi = 8;
        void* kargs[] = {&a};
        hipError_t e = hipLaunchCooperativeKernel((const void*)hymba_fwd, dim3(grid), dim3(NTHREADS), kargs, LDS_BYTES, stream);
        if (e != hipSuccess) fprintf(stderr, "kernel_launch: cooperative launch failed: %s (grid %d)\n", hipGetErrorString(e), grid);
    } else {
        for (int p = 0; p < 8; ++p) { a.ph_lo = p; a.ph_hi = p + 1; hipLaunchKernelGGL(hymba_fwd, dim3(grid), dim3(NTHREADS), LDS_BYTES, stream, a); }
    }
}
```

```cpp
#include <hip/hip_runtime.h>
#include <hip/hip_cooperative_groups.h>
#include <cstdint>
#include <cstdio>
namespace cg = cooperative_groups;

#ifndef MK_N_LAUNCHES
#define MK_N_LAUNCHES 1
#endif

#define LAS __attribute__((address_space(3)))
typedef unsigned short bf16_t;
typedef short bf16x8 __attribute__((ext_vector_type(8)));
typedef short s16x4 __attribute__((ext_vector_type(4)));
typedef float f32x4 __attribute__((ext_vector_type(4)));
typedef float f32x2 __attribute__((ext_vector_type(2)));
typedef unsigned u32x4 __attribute__((ext_vector_type(4)));
typedef unsigned u32x2 __attribute__((ext_vector_type(2)));
typedef __bf16 bf16x2_t __attribute__((ext_vector_type(2)));

constexpr int DM = 2048, SEQ = 8192, NB = 2, MP = NB * SEQ, NSEQ_S = 128, TS = 4, MS = NSEQ_S * TS, MT = MP + MS;
constexpr int DRNN = 1024, DATT = 1024, NPROJ = 3584, DFF = 6144, NUP = 12288, NHEAD = 16, KVH = 4, HD = 64;
constexpr int COL_XR = 0, COL_GR = 1024, COL_Q = 2048, COL_K = 3072, COL_V = 3328;
constexpr float EPS = 1e-6f;
constexpr int NTHREADS = 512, NWAVES = 8;
constexpr size_t O_Y = 0, O_P_RCONV = (size_t)MT * DM, O_P_RH = O_P_RCONV + 2 * 3 * 1024, O_P_WK = O_P_RH + 2 * 1024, O_P_WV = O_P_WK + 2 * 128 * 256,
                 O_P_FFN = O_P_WV + 2 * 128 * 256, O_S_RCONV = O_P_FFN + 2 * 2 * NUP, O_S_RH = O_S_RCONV + 128 * 3 * 1024, O_S_WK = O_S_RH + 128 * 1024,
                 O_S_WV = O_S_WK + (size_t)128 * 128 * 256, O_S_FFN = O_S_WV + (size_t)128 * 128 * 256, O_END = O_S_FFN + (size_t)128 * 2 * NUP;
static_assert(O_END == 46850048, "output size");
constexpr size_t MiB = 1u << 20;
constexpr size_t WS_CTL = 0, CTL_BYTES = 1 * MiB;
constexpr size_t CT_SS_RNN = 128 * 1024, CT_SS_ATT = 256 * 1024, CT_SS_H = 384 * 1024, CT_SS_OUT = 512 * 1024;
constexpr size_t CT_PCNT = 736 * 1024;
constexpr size_t CT_BAR3 = 724 * 1024;
constexpr size_t CT_RSTD_X = 512 * 1024;
constexpr size_t CT_BAR2 = 720 * 1024;
constexpr size_t CT_BAR = 640 * 1024;
constexpr size_t WS_WG = 1 * MiB;
constexpr size_t WS_XCH = 3 * MiB + 64 * 1024;
constexpr size_t WS_DUMP = 3 * MiB;
constexpr size_t WS_SUMM = 2 * MiB;
constexpr size_t WS_WIN = 4 * MiB, WS_WOUT = 18 * MiB, WS_WUP = 26 * MiB, WS_WDOWN = 74 * MiB;
constexpr size_t WS_XN = 100 * MiB;
constexpr size_t WS_PROJ = 168 * MiB;
constexpr size_t WS_MERGED = 284 * MiB;
constexpr size_t WS_ACT = 168 * MiB;
constexpr size_t WS_SLAB = 368 * MiB;
constexpr size_t WS_DU = WS_SLAB;
constexpr size_t WS_END = 432 * MiB;
static_assert(WS_ACT + (size_t)MT * DFF * 2 <= WS_END && WS_MERGED + (size_t)MT * DM * 2 <= WS_END && WS_PROJ + (size_t)MT * NPROJ * 2 <= WS_MERGED, "ws map");
constexpr int LDS_BYTES = 147456;
constexpr int LDS_MISC = LDS_BYTES - 256;

__device__ __forceinline__ unsigned pk2(float lo, float hi) { f32x2 v = {lo, hi}; bf16x2_t b = __builtin_convertvector(v, bf16x2_t); return __builtin_bit_cast(unsigned, b); }
__device__ __forceinline__ float bf2f(unsigned short h) { return __uint_as_float((unsigned)h << 16); }
__device__ __forceinline__ float bflo(unsigned w) { return __uint_as_float(w << 16); }
__device__ __forceinline__ float bfhi(unsigned w) { return __uint_as_float(w & 0xffff0000u); }
__device__ __forceinline__ float wave_sum(float v) {
#pragma unroll
    for (int o = 1; o < 64; o <<= 1) v += __shfl_xor(v, o);
    return v;
}
__device__ __forceinline__ float sigmoidf_(float x) { return __builtin_amdgcn_rcpf(1.0f + __builtin_amdgcn_exp2f(-1.4426950408889634f * x)); }
__device__ __forceinline__ float gelu_tanh(float x) {
    const float t = x * (2.3022082f + 0.1029432f * x * x);
    return x * __builtin_amdgcn_rcpf(1.0f + __builtin_amdgcn_exp2f(-t));
}
__device__ __forceinline__ f32x4 gelu_mul4(const f32x4 x, const f32x4 v) {
    const f32x4 t = x * (x * x * 0.1029432f + 2.3022082f);
    f32x4 e; e[0] = __builtin_amdgcn_exp2f(-t[0]); e[1] = __builtin_amdgcn_exp2f(-t[1]); e[2] = __builtin_amdgcn_exp2f(-t[2]); e[3] = __builtin_amdgcn_exp2f(-t[3]);
    const f32x4 d = e + 1.0f;
    f32x4 r; r[0] = __builtin_amdgcn_rcpf(d[0]); r[1] = __builtin_amdgcn_rcpf(d[1]); r[2] = __builtin_amdgcn_rcpf(d[2]); r[3] = __builtin_amdgcn_rcpf(d[3]);
    return (x * v) * r;
}
#define LDS_WAIT() asm volatile("s_waitcnt lgkmcnt(0)" ::: "memory")
#define LDS_BARRIER() do { asm volatile("s_waitcnt lgkmcnt(0)" ::: "memory"); __builtin_amdgcn_s_barrier(); asm volatile("" ::: "memory"); } while (0)

namespace gm {
constexpr unsigned XB_SPIN_CAP_ = 1u << 22;
constexpr int BM = 256, BK = 64, HALF = 128, HTB = HALF * BK * 2, STAGE_BYTES = 8 * HTB, NXCD = 8, WGM = 8;
__host__ __device__ __forceinline__ int lds_byte(int r, int c) { const int st = (r >> 4) * 2 + (c >> 5), rr = r & 15, cc = c & 31, ob = rr * 64 + cc * 2; return st * 1024 + (ob ^ (((ob >> 9) & 1) << 5)); }
__host__ __device__ __forceinline__ void stage_rc(int b, int& R, int& C) { const int st = b / 1024, sb = b % 1024, swz = sb ^ (((sb >> 9) & 1) << 5); R = (st >> 1) * 16 + swz / 64; C = (st & 1) * 32 + (swz % 64) / 2; }
__host__ __device__ __forceinline__ int perm32(int rho) { const int n = rho >> 4, i = rho & 15; return 8 * (i >> 2) + 4 * n + (i & 3); }

struct Unit { int pm, pn; int rowbase, seg; int k0; };
template <int ROWMODE> struct Order {
    int nM, nN, nwg, G, c;
    __device__ void init(int nM_, int nN_, int G_, int c_) { nM = nM_; nN = nN_; nwg = nM * nN; G = G_; c = c_; }
    __device__ bool next(int i, Unit& u) const {
        const long L = (long)i * G + c; if (L >= nwg) return false;
        int wgid = (int)L; { const int q = nwg / NXCD, r = nwg % NXCD, xcd = wgid % NXCD, off = wgid / NXCD; wgid = (xcd < r ? xcd * (q + 1) : r * (q + 1) + (xcd - r) * q) + off; }
        const int nig = WGM * nN, gid = wgid / nig, fm = gid * WGM, gsz = (nM - fm) < WGM ? (nM - fm) : WGM;
        if (ROWMODE == 3) { u.pm = fm + (wgid % nig) / nN; u.pn = (wgid % nig) % nN; }
        else { u.pm = fm + ((wgid % nig) % gsz); u.pn = (wgid % nig) / gsz; }
        u.k0 = 0;
        if (ROWMODE == 0 || ROWMODE == 3) { u.rowbase = u.pm * 256; u.seg = 128; }
        else if (ROWMODE == 1) { const int b = u.pm / 33, pmb = u.pm % 33; u.rowbase = b * SEQ + 252 * pmb - 2; u.seg = 126; }
        else { u.rowbase = MP + 256 * u.pm; u.seg = 128; }
        return true;
    }
};

struct SplitOrder {
    int KS, kper, G, c;
    __device__ void init(int KS_, int kper_, int G_, int c_) { KS = KS_; kper = kper_; G = G_; c = c_; }
    __device__ bool next(int i, Unit& u) const {
        const int L = i * G + c; if (L >= 16 * KS) return false;
        const int tile = L / KS, sp = L % KS;
        u.pm = 64 + (tile >> 3); u.pn = tile & 7; u.rowbase = 256 * u.pm; u.seg = 128; u.k0 = sp * kper; return true;
    }
};

template <class Epi, class Sched>
__device__ __forceinline__ void gemm_phase(LAS unsigned char* lds, const bf16_t* A, const bf16_t* Bt, const int K  , const int nt  , const Sched& S, const Epi& E) {
    const int tid = threadIdx.x, wid = __builtin_amdgcn_readfirstlane(tid >> 6), lane = tid & 63, wr = wid >> 2, wc = wid & 3, fr = lane & 15, fq = lane >> 4;
    unsigned voffA, voffB[2];
    { int R, C; stage_rc(tid * 16, R, C); voffA = (unsigned)(R * K + C) * 2u; }
#pragma unroll
    for (int i = 0; i < 2; ++i) { int R, C; stage_rc(tid * 16 + i * 8192, R, C); const int Rb = Epi::PERM ? ((R & ~31) + perm32(R & 31)) : R; voffB[i] = (unsigned)(Rb * K + C) * 2u; }
    const size_t kstep = (size_t)(BK * 2);
    const size_t hstepB = (size_t)HALF * K * 2, tstepB = 2 * hstepB;
    const size_t hstepA = (size_t)64 * K * 2, rowB = (size_t)K * 2;
    const unsigned ldsw = (unsigned)wid * 1024u;
    const int aoff = lds_byte(wr * 64 + fr, fq * 8), boff = lds_byte(wc * 32 + fr, fq * 8);
#define G_SA(b, h) (((b) * 2 + (h)) * HTB)
#define G_SB(b, h) ((4 + (b) * 2 + (h)) * HTB)
#define G_STAGEB(bufoff, gbase) do { _Pragma("unroll") for (int _i = 0; _i < 2; ++_i) \
        __builtin_amdgcn_global_load_lds((const unsigned*)((const char*)(gbase) + voffB[_i]), (LAS unsigned*)(lds + (bufoff) + ldsw + _i * 8192), 16, 0, 0); } while (0)
#define G_STAGEA(bufoff, gbase, segb) do { \
        __builtin_amdgcn_global_load_lds((const unsigned*)((const char*)(gbase) + voffA), (LAS unsigned*)(lds + (bufoff) + ldsw), 16, 0, 0); \
        __builtin_amdgcn_global_load_lds((const unsigned*)((const char*)(gbase) + (segb) + voffA), (LAS unsigned*)(lds + (bufoff) + ldsw + 8192), 16, 0, 0); } while (0)
#define G_LDA(dst, b, h) do { _Pragma("unroll") for (int m = 0; m < 4; ++m) _Pragma("unroll") for (int k = 0; k < 2; ++k) dst[m][k] = *(const LAS bf16x8*)(lds + G_SA(b, h) + aoff + m * 2048 + k * 1024); } while (0)
#define G_LDB(dst, b, h) do { _Pragma("unroll") for (int n = 0; n < 2; ++n) _Pragma("unroll") for (int k = 0; k < 2; ++k) dst[n][k] = *(const LAS bf16x8*)(lds + G_SB(b, h) + boff + n * 2048 + k * 1024); } while (0)
#define G_MMA(ai, bj, At, Bt_) do { __builtin_amdgcn_s_setprio(3); _Pragma("unroll") for (int m = 0; m < 4; ++m) _Pragma("unroll") for (int n = 0; n < 2; ++n) _Pragma("unroll") for (int k = 0; k < 2; ++k) \
        acc[ai][bj][m][n] = __builtin_amdgcn_mfma_f32_16x16x32_bf16(Bt_[n][k], At[m][k], acc[ai][bj][m][n], 0, 0, 0); __builtin_amdgcn_s_setprio(0); } while (0)
#define G_WAIT_V(n) asm volatile("s_waitcnt vmcnt(" #n ")" ::: "memory")
#define G_WAIT_L(n) asm volatile("s_waitcnt lgkmcnt(" #n ")" ::: "memory")
#define G_BAR __builtin_amdgcn_s_barrier()
#define G_SCHED __builtin_amdgcn_sched_barrier(0)
    Unit cur, nxt; int ui = 0;
    if (!S.next(0, cur)) return;
    f32x4 acc[2][2][4][2];
#pragma unroll
    for (int a = 0; a < 2; ++a)
#pragma unroll
        for (int b = 0; b < 2; ++b)
#pragma unroll
            for (int m = 0; m < 4; ++m)
#pragma unroll
                for (int n = 0; n < 2; ++n) acc[a][b][m][n] = (f32x4){0.f, 0.f, 0.f, 0.f};
    bf16x8 At[4][2], B0[2][2], B1[2][2];
    const char* cA = (const char*)A + (long)cur.rowbase * (long)rowB + (long)cur.k0 * 2; size_t cS = (size_t)cur.seg * rowB;
    const char* cB = (const char*)Bt + (size_t)cur.pn * tstepB + (size_t)cur.k0 * 2;
    E.pre(cur, wid, wr, lane);
    G_STAGEB(G_SB(0, 0), cB); G_STAGEB(G_SB(0, 1), cB + hstepB); G_STAGEA(G_SA(0, 0), cA, cS); G_STAGEA(G_SA(0, 1), cA + hstepA, cS);
    if (wr == 1) G_BAR;
    G_WAIT_V(2); G_BAR;
    G_STAGEB(G_SB(1, 0), cB + kstep); G_STAGEA(G_SA(1, 0), cA + kstep, cS); G_STAGEB(G_SB(1, 1), cB + hstepB + kstep);
    G_WAIT_V(6); G_BAR;
    for (;;) {
        const bool has_next = S.next(ui + 1, nxt);
        const char* nA = has_next ? (const char*)A + (long)nxt.rowbase * (long)rowB + (long)nxt.k0 * 2 : cA; const size_t nS = has_next ? (size_t)nxt.seg * rowB : cS;
        const char* nB = has_next ? (const char*)Bt + (size_t)nxt.pn * tstepB + (size_t)nxt.k0 * 2 : cB;
#pragma clang loop unroll(disable)
        for (int t = 0; t < nt; t += 2) {
            const bool last = (t == nt - 2);
            if constexpr (Epi::MID) { if (t == nt / 2) E.mid(acc, cur, wid, wr, fr); }
            const char* a1 = cA + (size_t)(t + 1) * kstep;
            const char* a2 = last ? nA : cA + (size_t)(t + 2) * kstep; const char* b2 = last ? nB : cB + (size_t)(t + 2) * kstep;
            const size_t s2 = last ? nS : cS;
            const char* a3 = a2 + kstep; const char* b3 = b2 + kstep;
            G_LDB(B0, 0, 0); G_LDB(B1, 0, 1); G_SCHED; G_LDA(At, 0, 0); G_STAGEA(G_SA(1, 1), a1 + hstepA, cS);
            G_WAIT_V(8); G_WAIT_L(0); G_BAR; G_MMA(0, 0, At, B0); G_MMA(0, 1, At, B1); G_BAR; G_SCHED;
            G_LDA(At, 0, 1); G_STAGEB(G_SB(0, 0), b2); G_STAGEB(G_SB(0, 1), b2 + hstepB); G_STAGEA(G_SA(0, 0), a2, s2);
            G_WAIT_V(8); G_WAIT_L(0); G_BAR; G_MMA(1, 0, At, B0); G_MMA(1, 1, At, B1); G_BAR; G_SCHED;
            G_LDB(B0, 1, 0); G_LDB(B1, 1, 1); G_SCHED; G_LDA(At, 1, 0); G_STAGEA(G_SA(0, 1), a2 + hstepA, s2);
            G_WAIT_V(8); G_WAIT_L(0); G_BAR; G_MMA(0, 0, At, B0); G_MMA(0, 1, At, B1); G_BAR; G_SCHED;
            G_LDA(At, 1, 1); G_STAGEB(G_SB(1, 0), b3); G_STAGEB(G_SB(1, 1), b3 + hstepB); G_STAGEA(G_SA(1, 0), a3, s2);
            G_WAIT_V(8); G_WAIT_L(0); G_BAR; G_MMA(1, 0, At, B0); G_MMA(1, 1, At, B1); G_BAR; G_SCHED;
        }
        if (wr == 0) G_BAR;
        { int fr_ = fr, fq_ = fq; asm volatile("" : "+v"(fr_), "+v"(fq_)); E(acc, cur, wid, wr, wc, fr_, fq_); }
        if (!has_next) break;
        E.pre(nxt, wid, wr, lane);
#pragma unroll
        for (int a = 0; a < 2; ++a)
#pragma unroll
            for (int b = 0; b < 2; ++b)
#pragma unroll
                for (int m = 0; m < 4; ++m)
#pragma unroll
                    for (int n = 0; n < 2; ++n) acc[a][b][m][n] = (f32x4){0.f, 0.f, 0.f, 0.f};
        cur = nxt; cA = nA; cS = nS; cB = nB; ++ui;
        if (wr == 1) G_BAR;
    }
    G_WAIT_V(0);
    G_BAR;
#undef G_SA
#undef G_SB
#undef G_STAGEA
#undef G_STAGEB
#undef G_LDA
#undef G_LDB
#undef G_MMA
#undef G_WAIT_V
#undef G_WAIT_L
#undef G_BAR
#undef G_SCHED
}

struct EpiProj {
    static constexpr bool PERM = true, MID = false;
    bf16_t* O; int ldc; const float* rsx; LAS float* tab;
    __device__ __forceinline__ void pre(const Unit& u, int wid, int wr, int lane) const {
        LAS float* T = tab + wid * 128;
#pragma unroll
        for (int k = 0; k < 2; ++k) __builtin_amdgcn_global_load_lds((const unsigned*)(rsx + u.rowbase + u.seg * wr + lane + 64 * k), (LAS unsigned*)(T + 64 * k), 4, 0, 0);
    }
    __device__ __forceinline__ void mid(f32x4 (&)[2][2][4][2], const Unit&, int, int, int) const {}
    __device__ __forceinline__ void operator()(f32x4 (&acc)[2][2][4][2], const Unit& u, int wid, int wr, int wc, int fr, int fq) const {
        const int row0 = u.rowbase + u.seg * wr + fr, col0 = u.pn * BM + wc * 32 + 8 * fq;
        const LAS float* T = tab + wid * 128;
        float rs[8];
#pragma unroll
        for (int g = 0; g < 8; ++g) rs[g] = T[(g >> 2) * 64 + (g & 3) * 16 + fr];
#pragma unroll
        for (int ai = 0; ai < 2; ++ai)
#pragma unroll
            for (int m = 0; m < 4; ++m) { bf16_t* rowp = O + (size_t)(row0 + ai * 64 + m * 16) * ldc + col0; const float f = rs[ai * 4 + m];
#pragma unroll
                for (int bj = 0; bj < 2; ++bj) { const f32x4 v0 = acc[ai][bj][m][0] * f, v1 = acc[ai][bj][m][1] * f;
                    u32x4 w; w.x = pk2(v0[0], v0[1]); w.y = pk2(v0[2], v0[3]); w.z = pk2(v1[0], v1[1]); w.w = pk2(v1[2], v1[3]);
                    *(u32x4*)(rowp + bj * HALF) = w; } }
    }
};
struct EpiH {
    static constexpr bool PERM = false, MID = true;
    const float* xp; const float* xs; bf16_t* HB; const float* ss_rnn; const float* ss_att; float* ss_h; LAS float* tab;
    __device__ __forceinline__ void pre(const Unit& u, int wid, int wr, int lane) const {
        LAS float* T = tab + wid * 256;
#pragma unroll
        for (int i = 0; i < 2; ++i) { const int s = lane + 64 * i, row = u.rowbase + u.seg * wr + s;
            const float sr = __builtin_amdgcn_rsqf(ss_rnn[row] * (1.0f / 1024.0f) + EPS), sa = __builtin_amdgcn_rsqf(ss_att[row] * (1.0f / 1024.0f) + EPS);
            T[s] = sr * __builtin_amdgcn_rcpf(sa); T[128 + s] = sa; }
    }
    __device__ __forceinline__ void mid(f32x4 (&acc)[2][2][4][2], const Unit& u, int wid, int wr, int fr) const {
        const LAS float* T = tab + wid * 256;
#pragma unroll
        for (int ai = 0; ai < 2; ++ai)
#pragma unroll
            for (int m = 0; m < 4; ++m) { const float f = T[64 * ai + 16 * m + fr];
#pragma unroll
                for (int bj = 0; bj < 2; ++bj)
#pragma unroll
                    for (int n = 0; n < 2; ++n) acc[ai][bj][m][n] = acc[ai][bj][m][n] * f; }
    }
    __device__ __forceinline__ void operator()(f32x4 (&acc)[2][2][4][2], const Unit& u, int wid, int wr, int wc, int fr, int fq) const {
        const LAS float* T = tab + wid * 256;
        const int row0 = u.rowbase + u.seg * wr + fr, col0 = u.pn * BM + wc * 32 + 4 * fq;
        const bf16_t* xb = HB + (size_t)row0 * DM + col0;
        u32x2 xv[8][2][2];
#pragma unroll
        for (int g = 0; g < 8; ++g)
#pragma unroll
            for (int bj = 0; bj < 2; ++bj)
#pragma unroll
                for (int n = 0; n < 2; ++n) xv[g][bj][n] = *(const u32x2*)(xb + (size_t)((g >> 2) * 64 + (g & 3) * 16) * DM + bj * HALF + n * 16);
        float q[8];
#pragma unroll
        for (int g = 0; g < 8; ++g) { const int ai = g >> 2, m = g & 3, row = row0 + ai * 64 + m * 16;
            const float sa = T[128 + 64 * ai + 16 * m + fr];
            float qq = 0.f;
#pragma unroll
            for (int bj = 0; bj < 2; ++bj)
#pragma unroll
                for (int n = 0; n < 2; ++n) { const int c = col0 + bj * HALF + n * 16; const u32x2 hw = xv[g][bj][n];
                    f32x4 h = acc[ai][bj][m][n] * sa; h[0] += bflo(hw.x); h[1] += bfhi(hw.x); h[2] += bflo(hw.y); h[3] += bfhi(hw.y);
                    u32x2 w; w.x = pk2(h[0], h[1]); w.y = pk2(h[2], h[3]); *(u32x2*)(HB + (size_t)row * DM + c) = w;
                    qq += (h[0] * h[0] + h[1] * h[1]) + (h[2] * h[2] + h[3] * h[3]); }
            q[g] = qq; }
#pragma unroll
        for (int g = 0; g < 8; ++g) { float s = q[g]; s += __shfl_xor(s, 16); s += __shfl_xor(s, 32);
            if (fq == 0) atomicAdd(ss_h + row0 + (g >> 2) * 64 + (g & 3) * 16, s); }
    }
};
struct EpiOutNorm {
    static constexpr bool PERM = false, MID = false;
    const bf16_t* HB; float* Y; const float* gfin; float* xch; unsigned* pcnt; unsigned* tmo; LAS float* tab;
    __device__ __forceinline__ void pre(const Unit&, int, int, int) const {}
    __device__ __forceinline__ void mid(f32x4 (&)[2][2][4][2], const Unit&, int, int, int) const {}
    __device__ __forceinline__ void operator()(f32x4 (&acc)[2][2][4][2], const Unit& u, int wid, int wr, int wc, int fr, int fq) const {
        const int lane = fq * 16 + fr, tid = wid * 64 + lane;
        const int row0 = u.rowbase + u.seg * wr + fr, col0 = u.pn * BM + wc * 32 + 4 * fq;
        const bf16_t* hb = HB + (size_t)row0 * DM + col0;
        LAS float* P = tab; LAS float* S = tab + 1024;
        u32x2 hv[8][2][2];
#pragma unroll
        for (int g = 0; g < 8; ++g)
#pragma unroll
            for (int bj = 0; bj < 2; ++bj)
#pragma unroll
                for (int n = 0; n < 2; ++n) hv[g][bj][n] = *(const u32x2*)(hb + (size_t)((g >> 2) * 64 + (g & 3) * 16) * DM + bj * HALF + n * 16);
#pragma unroll
        for (int g = 0; g < 8; ++g) { const int ai = g >> 2, m = g & 3;
            float q = 0.f;
#pragma unroll
            for (int bj = 0; bj < 2; ++bj)
#pragma unroll
                for (int n = 0; n < 2; ++n) { const u32x2 hw = hv[g][bj][n]; f32x4 o = acc[ai][bj][m][n];
                    o[0] += bflo(hw.x); o[1] += bfhi(hw.x); o[2] += bflo(hw.y); o[3] += bfhi(hw.y); acc[ai][bj][m][n] = o;
                    q += (o[0] * o[0] + o[1] * o[1]) + (o[2] * o[2] + o[3] * o[3]); }
            q += __shfl_xor(q, 16); q += __shfl_xor(q, 32);
            if (fq == 0) P[(wr * 128 + ai * 64 + m * 16 + fr) * 4 + wc] = q; }
        LDS_BARRIER();
        if (tid < 256) { const f32x4 p4 = *(const LAS f32x4*)(P + tid * 4); const float part = (p4[0] + p4[1]) + (p4[2] + p4[3]);
            unsigned* sl = (unsigned*)(xch + ((size_t)u.pm * 256 + tid) * 8);
            __hip_atomic_store(sl + u.pn, __float_as_uint(part) | 0x80000000u, __ATOMIC_RELAXED, __HIP_MEMORY_SCOPE_AGENT);
            unsigned sp = 0; float ssum = 0.f;
            for (;;) { unsigned v[8]; unsigned all = 0x80000000u;
#pragma unroll
                for (int t = 0; t < 8; ++t) { v[t] = __hip_atomic_load(sl + t, __ATOMIC_RELAXED, __HIP_MEMORY_SCOPE_AGENT); all &= v[t]; }
                ssum = 0.f;
#pragma unroll
                for (int t = 0; t < 8; ++t) ssum += __uint_as_float(v[t] & 0x7fffffffu);
                if (all) break;
                __builtin_amdgcn_s_sleep(2);
                if (++sp > (1u << 18)) { atomicAdd(tmo, 1u); break; } }
            S[tid] = __builtin_amdgcn_rsqf(ssum * (1.0f / DM) + EPS); }
        LDS_BARRIER();
        f32x4 gg[2][2];
#pragma unroll
        for (int bj = 0; bj < 2; ++bj)
#pragma unroll
            for (int n = 0; n < 2; ++n) gg[bj][n] = *(const f32x4*)(gfin + col0 + bj * HALF + n * 16);
        float* yb = Y + (size_t)row0 * DM + col0;
#pragma unroll
        for (int g = 0; g < 8; ++g) { const int ai = g >> 2, m = g & 3; const float rs = S[wr * 128 + ai * 64 + m * 16 + fr];
#pragma unroll
            for (int bj = 0; bj < 2; ++bj)
#pragma unroll
                for (int n = 0; n < 2; ++n) *(f32x4*)(yb + (size_t)(ai * 64 + m * 16) * DM + bj * HALF + n * 16) = acc[ai][bj][m][n] * rs * gg[bj][n]; }
        LDS_WAIT();
    }
};
template <bool SCALED> struct EpiSlab {
    static constexpr bool PERM = false, MID = false;
    float* slab; int kper; const float* ss_rnn; const float* ss_att; LAS float* tab;
    __device__ __forceinline__ void pre(const Unit& u, int wid, int wr, int lane) const {
        if (SCALED) { LAS float* T = tab + wid * 256; const float* ss = (u.k0 < DRNN) ? ss_rnn : ss_att;
#pragma unroll
            for (int i = 0; i < 2; ++i) { const int s = lane + 64 * i, row = u.rowbase + u.seg * wr + s; T[s] = __builtin_amdgcn_rsqf(ss[row] * (1.0f / 1024.0f) + EPS); } }
    }
    __device__ __forceinline__ void mid(f32x4 (&)[2][2][4][2], const Unit&, int, int, int) const {}
    __device__ __forceinline__ void operator()(f32x4 (&acc)[2][2][4][2], const Unit& u, int wid, int wr, int wc, int fr, int fq) const {
        const LAS float* T = tab + wid * 256;
        const int row0 = u.rowbase - MP + u.seg * wr + fr, col0 = u.pn * BM + wc * 32 + 4 * fq;
        float* S = slab + (size_t)(u.k0 / kper) * MS * DM;
#pragma unroll
        for (int ai = 0; ai < 2; ++ai)
#pragma unroll
            for (int m = 0; m < 4; ++m) { const int row = row0 + ai * 64 + m * 16; const float sc = SCALED ? T[64 * ai + 16 * m + fr] : 1.0f;
#pragma unroll
                for (int bj = 0; bj < 2; ++bj)
#pragma unroll
                    for (int n = 0; n < 2; ++n) *(f32x4*)(S + (size_t)row * DM + col0 + bj * HALF + n * 16) = acc[ai][bj][m][n] * sc; }
    }
};
__device__ __forceinline__ float dpp_shr1(float oldv, float src) { return __builtin_bit_cast(float, __builtin_amdgcn_update_dpp(__builtin_bit_cast(int, oldv), __builtin_bit_cast(int, src), 0x111, 0xf, 0xf, false)); }
__device__ __forceinline__ float dpp_shr2(float oldv, float src) { return __builtin_bit_cast(float, __builtin_amdgcn_update_dpp(__builtin_bit_cast(int, oldv), __builtin_bit_cast(int, src), 0x112, 0xf, 0xf, false)); }
__device__ __forceinline__ float dpp_ror1(float src) { return __builtin_bit_cast(float, __builtin_amdgcn_update_dpp(0, __builtin_bit_cast(int, src), 0x121, 0xf, 0xf, false)); }
__device__ __forceinline__ float dpp_ror2(float src) { return __builtin_bit_cast(float, __builtin_amdgcn_update_dpp(0, __builtin_bit_cast(int, src), 0x122, 0xf, 0xf, false)); }
__device__ __forceinline__ void conv_taps_dpp(f32x4& upc, const f32x4 X, const f32x4 Xp, const f32x4 w1, const f32x4 w1m, const f32x4 w0, const f32x4 w0m) {
#define CT_E(e) asm volatile("s_nop 1\n\t" \
        "v_fmac_f32_dpp %0, %1, %3 row_shr:1 row_mask:0xf bank_mask:0xf bound_ctrl:1\n\t" \
        "v_fmac_f32_dpp %0, %2, %4 row_ror:1 row_mask:0xf bank_mask:0xf bound_ctrl:1\n\t" \
        "v_fmac_f32_dpp %0, %1, %5 row_shr:2 row_mask:0xf bank_mask:0xf bound_ctrl:1\n\t" \
        "v_fmac_f32_dpp %0, %2, %6 row_ror:2 row_mask:0xf bank_mask:0xf bound_ctrl:1" \
        : "+v"(u##e) : "v"(x##e), "v"(p##e), "v"(a##e), "v"(b##e), "v"(c##e), "v"(d##e))
    float u0 = upc[0], u1 = upc[1], u2 = upc[2], u3 = upc[3];
    const float x0 = X[0], x1 = X[1], x2 = X[2], x3 = X[3], p0 = Xp[0], p1 = Xp[1], p2 = Xp[2], p3 = Xp[3];
    const float a0 = w1[0], a1 = w1[1], a2 = w1[2], a3 = w1[3], b0 = w1m[0], b1 = w1m[1], b2 = w1m[2], b3 = w1m[3];
    const float c0 = w0[0], c1 = w0[1], c2 = w0[2], c3 = w0[3], d0 = w0m[0], d1 = w0m[1], d2 = w0m[2], d3 = w0m[3];
    CT_E(0); CT_E(1); CT_E(2); CT_E(3);
    upc = (f32x4){u0, u1, u2, u3};
#undef CT_E
}
template <bool SAMPLE> struct EpiAct {
    static constexpr bool PERM = true, MID = false;
    bf16_t* ACT; const float* ss_h; const float* cw; const float* cb; const float* st_ffn; float* o_p_ffn; float* o_s_ffn; unsigned char* wsb; LAS float* tab;
    __device__ __forceinline__ void pre(const Unit& u, int wid, int wr, int lane) const {
        LAS float* T = tab + wid * 384;
        { const int a = lane >> 4, bj = (lane >> 3) & 1, i = lane & 7, wc = wid & 3;
          const float* srcp = (a < 3 ? cw + (size_t)a * NUP : cb) + bj * DFF + u.pn * 128 + wc * 32 + 4 * i;
          __builtin_amdgcn_global_load_lds((const unsigned*)srcp, (LAS unsigned*)T, 16, 0, 0); }
#pragma unroll
        for (int k = 0; k < 2; ++k) { const int s = lane + 64 * k, row = u.rowbase + u.seg * wr + s;
            __builtin_amdgcn_global_load_lds((const unsigned*)(ss_h + (row < 0 ? 0 : row)), (LAS unsigned*)(T + 256 + 64 * k), 4, 0, 0); }
    }
    __device__ __forceinline__ void mid(f32x4 (&)[2][2][4][2], const Unit&, int, int, int) const {}
    __device__ __forceinline__ void operator()(f32x4 (&acc)[2][2][4][2], const Unit& u, int wid, int wr, int wc, int fr, int fq) const {
        constexpr bool sample = SAMPLE;
        const int segrow0 = u.rowbase + u.seg * wr;
        const int jcol = u.pn * 128 + wc * 32 + 8 * fq;
        const int bstart = sample ? 0 : (u.pm / 33) * SEQ;
        const unsigned dump_off = (unsigned)WS_DUMP + (unsigned)(wid * 64 + fq * 16 + fr) * 16u;
        const unsigned act_off = (unsigned)WS_ACT + (unsigned)segrow0 * (unsigned)(DFF * 2) + (unsigned)jcol * 2u;
        const int smax = SEQ - (segrow0 - bstart);
        const LAS float* T = tab + wid * 384;
#pragma unroll
        for (int ai = 0; ai < 2; ++ai)
#pragma unroll
            for (int m = 0; m < 4; ++m) { float rs = __builtin_amdgcn_rsqf(T[256 + 64 * ai + 16 * m + fr] * (1.0f / 2048.0f) + EPS);
                if (!sample && segrow0 + 64 * ai + 16 * m + fr < bstart) rs = 0.f;
#pragma unroll
                for (int bj = 0; bj < 2; ++bj)
#pragma unroll
                    for (int n = 0; n < 2; ++n) acc[ai][bj][m][n] = acc[ai][bj][m][n] * rs; }
        if constexpr (sample) {
            const int tt = fr & 3;
#pragma unroll
            for (int ai = 0; ai < 2; ++ai)
#pragma unroll
                for (int m = 0; m < 4; ++m) { const int row = segrow0 + ai * 64 + m * 16 + fr, sq = (row - MP) >> 2;
                    if (tt >= 2) {
#pragma unroll
                        for (int bj = 0; bj < 2; ++bj)
#pragma unroll
                            for (int n = 0; n < 2; ++n) *(f32x4*)(o_s_ffn + ((size_t)sq * 2 + (tt - 2)) * NUP + bj * DFF + jcol + 4 * n) = acc[ai][bj][m][n]; } }
            asm volatile("" ::: "memory");
#pragma unroll
            for (int n = 0; n < 2; ++n)
#pragma unroll
            for (int pass = 0; pass < 2; ++pass) {
                const int bj = 1 - pass, c = bj * DFF + jcol + 4 * n, ti = (bj * 8 + 2 * fq + n) * 4;
                const f32x4 w0 = *(const LAS f32x4*)(T + ti), w1 = *(const LAS f32x4*)(T + 64 + ti), w2 = *(const LAS f32x4*)(T + 128 + ti), bb = *(const LAS f32x4*)(T + 192 + ti);
                const f32x4 zero4 = {0.f, 0.f, 0.f, 0.f};
                const f32x4 w1z = (tt == 0) ? w1 : zero4, w1n = (tt == 0) ? zero4 : w1, w0z = (tt < 2) ? w0 : zero4, w0n = (tt < 2) ? zero4 : w0;
#pragma unroll
                for (int ai = 0; ai < 2; ++ai) {
                    f32x4 sA4[4], sB4[4];
#pragma unroll
                    for (int m = 0; m < 4; ++m) { const int sq = (segrow0 + ai * 64 + m * 16 + fr - MP) >> 2;
                        const float* sp = st_ffn + ((size_t)sq * 2 + 1) * NUP + c;
                        sB4[m] = *(const f32x4*)(sp);
                        sA4[m] = *(const f32x4*)(sp - (tt == 0 ? NUP : 0)); }
#pragma unroll
                    for (int m = 0; m < 4; ++m) {
                    const int row = segrow0 + ai * 64 + m * 16 + fr;
                    const f32x4 X = acc[ai][bj][m][n];
                    f32x4 upc = bb + w2 * X + w1z * sB4[m] + w0z * sA4[m];
#pragma unroll
                    for (int e = 0; e < 4; ++e) { float ue = upc[e]; const float xe = X[e], a1 = w1n[e], a0 = w0n[e];
                        asm volatile("s_nop 1\n\t"
                                     "v_fmac_f32_dpp %0, %1, %2 row_shr:1 row_mask:0xf bank_mask:0xf bound_ctrl:1\n\t"
                                     "v_fmac_f32_dpp %0, %1, %3 row_shr:2 row_mask:0xf bank_mask:0xf bound_ctrl:1"
                                     : "+v"(ue) : "v"(xe), "v"(a1), "v"(a0));
                        upc[e] = ue; }
                    if (pass == 0) acc[ai][1][m][n] = upc;
                    else {
                        upc = gelu_mul4(upc, acc[ai][1][m][n]);
                        u32x2 w; w.x = pk2(upc[0], upc[1]); w.y = pk2(upc[2], upc[3]); *(u32x2*)(ACT + (size_t)row * DFF + jcol + 4 * n) = w;
                    }
                    asm volatile("" ::: "memory");
                    __builtin_amdgcn_sched_barrier(0);
                    }
                }
            }
        } else {
            if (u.pm % 33 == 32) {
#pragma unroll
                for (int ai = 0; ai < 2; ++ai)
#pragma unroll
                    for (int m = 0; m < 4; ++m) { const int s = 64 * ai + 16 * m + fr, tl = segrow0 + s - bstart;
                        if (s >= 2 && (tl == SEQ - 2 || tl == SEQ - 1)) {
#pragma unroll
                            for (int bj = 0; bj < 2; ++bj)
#pragma unroll
                                for (int n = 0; n < 2; ++n) *(f32x4*)(o_p_ffn + ((size_t)(u.pm / 33) * 2 + (tl - (SEQ - 2))) * NUP + bj * DFF + jcol + 4 * n) = acc[ai][bj][m][n]; } }
                asm volatile("" ::: "memory");
            }
#pragma unroll
            for (int n = 0; n < 2; ++n)
#pragma unroll
            for (int pass = 0; pass < 2; ++pass) {
                const int bj = 1 - pass, c = bj * DFF + jcol + 4 * n, ti = (bj * 8 + 2 * fq + n) * 4;
                const f32x4 w0 = *(const LAS f32x4*)(T + ti), w1 = *(const LAS f32x4*)(T + 64 + ti), w2 = *(const LAS f32x4*)(T + 128 + ti), bb = *(const LAS f32x4*)(T + 192 + ti);
                const f32x4 w1m = (fr == 0) ? w1 : (f32x4){0.f, 0.f, 0.f, 0.f}, w0m = (fr < 2) ? w0 : (f32x4){0.f, 0.f, 0.f, 0.f};
#pragma unroll
                for (int g = 7; g >= 0; --g) { const int ai = g >> 2, m = g & 3, gp = (g > 0 ? g - 1 : 0);
                    const int s = 64 * ai + 16 * m + fr;
                    const f32x4 X = acc[ai][bj][m][n];
                    const f32x4 Xp = acc[gp >> 2][bj][gp & 3][n];
                    f32x4 upc = bb + w2 * X;
                    conv_taps_dpp(upc, X, Xp, w1, w1m, w0, w0m);
                    if (pass == 0) acc[ai][1][m][n] = upc;
                    else {
                        upc = gelu_mul4(upc, acc[ai][1][m][n]);
                        const unsigned px = pk2(upc[0], upc[1]), py = pk2(upc[2], upc[3]);
                        if (n == 0) { acc[ai][1][m][0][0] = __uint_as_float(px); acc[ai][1][m][0][1] = __uint_as_float(py); }
                        else {
                            const bool ok = (g > 0 || fr >= 2) && (s < smax);
                            const unsigned off = ok ? (act_off + (unsigned)s * (unsigned)(DFF * 2)) : dump_off;
                            *(u32x4*)(wsb + off) = (u32x4){__float_as_uint(acc[ai][1][m][0][0]), __float_as_uint(acc[ai][1][m][0][1]), px, py};
                        }
                    }
                    __builtin_amdgcn_sched_barrier(0);
                }
                asm volatile("" ::: "memory");
            }
        }
    }
};
}


#define XB_TMO      128
#define XB_XCNT(j)  (256  + 64 * (j))
#define XB_XSUB(j)  (1280 + 64 * (j))
#define XB_XGEN(j)  (2304 + 64 * (j))
#define XB_TOP      3328
#define XB_TOPGEN   3392
#define XCD_BAR_WORDS 3456
#define XB_SPIN_CAP (1u << 22)
__device__ __forceinline__ unsigned xb_ld(unsigned* p)              { return __hip_atomic_load(p, __ATOMIC_RELAXED, __HIP_MEMORY_SCOPE_AGENT); }
__device__ __forceinline__ unsigned xb_add(unsigned* p, unsigned v) { return __hip_atomic_fetch_add(p, v, __ATOMIC_RELAXED, __HIP_MEMORY_SCOPE_AGENT); }
__device__ __forceinline__ unsigned xb_xcc_id() { return (unsigned)__builtin_amdgcn_s_getreg((3 << 11) | 20) & 0xFu; }
#define XB_SPIN(cond, bar) do { unsigned _sp = 0; while (cond) { __builtin_amdgcn_s_sleep(1); \
    if ((++_sp & 255u) == 0u) { if (xb_ld(&(bar)[XB_TMO])) break; if (_sp > XB_SPIN_CAP) { atomicAdd(&(bar)[XB_TMO], 1u); break; } } } } while (0)
struct XcdBarrier { unsigned* bar; unsigned x; volatile LAS unsigned* st; };
__device__ __forceinline__ XcdBarrier xcd_barrier_post(unsigned* bar, volatile LAS unsigned* st) {
    XcdBarrier b; b.bar = bar; b.x = xb_xcc_id(); b.st = st;
    if (threadIdx.x == 0) (void)xb_add(&bar[XB_XCNT(b.x)], 1u);
    return b;
}
__device__ __forceinline__ void xcd_barrier_complete(unsigned* bar, unsigned x, unsigned& nloc, unsigned& nx) {
    const unsigned G = gridDim.x * gridDim.y * gridDim.z;
    unsigned sum, cnt, mine, sp = 0u;
    for (;;) {
        sum = 0u; cnt = 0u; mine = 0u;
#pragma unroll
        for (unsigned j = 0; j < 16; ++j) { const unsigned c = xb_ld(&bar[XB_XCNT(j)]); sum += c; cnt += (c > 0u) ? 1u : 0u; mine = (j == x) ? c : mine; }
        if (sum == G) break;
        __builtin_amdgcn_s_sleep(1);
        if ((++sp & 255u) == 0u) { if (xb_ld(&bar[XB_TMO])) break; if (sp > XB_SPIN_CAP) { atomicAdd(&bar[XB_TMO], 1u); break; } }
    }
    nloc = mine > 0u ? mine : 1u; nx = cnt > 0u ? cnt : 1u;
}
__device__ __forceinline__ void xcd_barrier(const XcdBarrier& b) {
    asm volatile("s_waitcnt vmcnt(0)" ::: "memory");
    __syncthreads();
    if (threadIdx.x == 0) {
        unsigned* bar = b.bar;
        __builtin_amdgcn_s_waitcnt(0);
        unsigned nloc = b.st[0], nx = b.st[1];
        if (nloc == 0u) { xcd_barrier_complete(bar, b.x, nloc, nx); b.st[0] = nloc; b.st[1] = nx; }
        const unsigned old = xb_add(&bar[XB_XSUB(b.x)], 1u);
        const unsigned gen = old / nloc;
        if (old + 1u == (gen + 1u) * nloc) {
            __builtin_amdgcn_fence(__ATOMIC_RELEASE, "agent");
            asm volatile("s_waitcnt vmcnt(0)" ::: "memory");
            const unsigned og = xb_add(&bar[XB_TOP], 1u);
            const unsigned tg = og / nx;
            if (og + 1u == (tg + 1u) * nx) xb_add(&bar[XB_TOPGEN], 1u);
            else XB_SPIN(xb_ld(&bar[XB_TOPGEN]) == tg, bar);
            __builtin_amdgcn_fence(__ATOMIC_ACQUIRE, "agent");
            xb_add(&bar[XB_XGEN(b.x)], 1u);
            asm volatile("s_waitcnt vmcnt(0)" ::: "memory");
        } else {
            XB_SPIN(xb_ld(&bar[XB_XGEN(b.x)]) == gen, bar);
            __builtin_amdgcn_fence(__ATOMIC_ACQUIRE, "agent");
            asm volatile("s_waitcnt vmcnt(0)" ::: "memory");
        }
    }
    __syncthreads();
}


__device__ __forceinline__ void split_arrive(unsigned* cnt) {
    asm volatile("s_waitcnt vmcnt(0)" ::: "memory");
    __syncthreads();
    if (threadIdx.x == 0) { __builtin_amdgcn_fence(__ATOMIC_RELEASE, "agent"); asm volatile("s_waitcnt vmcnt(0)" ::: "memory"); (void)xb_add(cnt, 1u); }
}
__device__ __forceinline__ void split_wait(unsigned* cnt, unsigned* tmo, unsigned target = 0u) {
    if (threadIdx.x == 0) { const unsigned G = target ? target : gridDim.x; unsigned sp = 0;
        while (xb_ld(cnt) < G) { __builtin_amdgcn_s_sleep(1); if ((++sp & 255u) == 0u) { if (xb_ld(tmo)) break; if (sp > XB_SPIN_CAP) { atomicAdd(tmo, 1u); break; } } }
        __builtin_amdgcn_fence(__ATOMIC_ACQUIRE, "agent"); asm volatile("s_waitcnt vmcnt(0)" ::: "memory"); }
    __syncthreads();
}

struct Args {
    const float* in[27]; float* out; unsigned char* ws; int ph_lo, ph_hi;
};
struct Ctx {
    LAS unsigned char* lds; int tid, lane, wave, bid, G;
    const float* const* in; float* out; unsigned char* ws;
};

template <bool UPMAP>
__device__ __forceinline__ void p0_transpose_item(const float* W, int K, int N, bf16_t* WT, const float* gk, LAS unsigned char* scr, int item, int lane) {
    const int nblk = N / 64, kb = item / nblk, nb = item % nblk, k0 = 64 * kb, n0 = 64 * nb;
    const int n4 = lane & 15, kg = lane >> 4;
    f32x4 v[4][4];
#pragma unroll
    for (int i = 0; i < 4; ++i)
#pragma unroll
        for (int j = 0; j < 4; ++j) v[i][j] = *(const f32x4*)(W + (size_t)(k0 + 16 * i + 4 * kg + j) * N + n0 + 4 * n4);
    if (gk) {
#pragma unroll
        for (int i = 0; i < 4; ++i) { const f32x4 g4 = *(const f32x4*)(gk + k0 + 16 * i + 4 * kg);
#pragma unroll
            for (int j = 0; j < 4; ++j) v[i][j] = v[i][j] * g4[j]; } }
#pragma unroll
    for (int i = 0; i < 4; ++i) {
        const int q = 4 * i + kg;
#pragma unroll
        for (int e = 0; e < 4; ++e) { const int n = 4 * n4 + e; u32x2 w; w.x = pk2(v[i][0][e], v[i][1][e]); w.y = pk2(v[i][2][e], v[i][3][e]);
            *(LAS u32x2*)(scr + n * 128 + ((q ^ n4) * 8)) = w; }
    }
    LDS_WAIT(); asm volatile("" ::: "memory");
    int d0 = n0;
    if (UPMAP) d0 = (n0 < DFF) ? (256 * (n0 / 128) + (n0 % 128)) : (256 * ((n0 - DFF) / 128) + 128 + ((n0 - DFF) % 128));
    const int c16 = lane & 7;
#pragma unroll
    for (int p = 0; p < 8; ++p) { const int n = (lane >> 3) + 8 * p, s = (n >> 2) & 15, pos = (2 * c16) ^ s;
        u32x4 r = *(const LAS u32x4*)(scr + n * 128 + (pos & ~1) * 8);
        if (s & 1) r = (u32x4){r.z, r.w, r.x, r.y};
        *(u32x4*)(WT + (size_t)(d0 + n) * K + k0 + 8 * c16) = r; }
    LDS_WAIT(); asm volatile("" ::: "memory");
}
__device__ __forceinline__ void convert_weights(const Ctx& F, int which, int part, int nparts) {
    LAS unsigned char* scr = F.lds + F.wave * 16384;
    const int gw = part * NWAVES + F.wave, NGW = nparts * NWAVES;
    bf16_t* WIN = (bf16_t*)(F.ws + WS_WIN); bf16_t* WOUT = (bf16_t*)(F.ws + WS_WOUT); bf16_t* WUP = (bf16_t*)(F.ws + WS_WUP); bf16_t* WDOWN = (bf16_t*)(F.ws + WS_WDOWN);
    constexpr int I_IN = (DM / 64) * (NPROJ / 64), I_OUT = (DM / 64) * (DM / 64), I_UP = (DM / 64) * (NUP / 64), I_DOWN = (DFF / 64) * (DM / 64);
    if (which & 1) for (int r = gw; r < I_IN; r += NGW) p0_transpose_item<false>(F.in[8], DM, NPROJ, WIN, F.in[7], scr, r, F.lane);
    if (which & 2) for (int r = gw; r < I_OUT; r += NGW) {
        const int nblk = DM / 64, kb = r / nblk; const float* g = (kb < 16) ? F.in[18] : (F.in[19] - 1024);
        p0_transpose_item<false>(F.in[20], DM, DM, WOUT, g, scr, r, F.lane); }
    if (which & 4) for (int r = gw; r < I_UP; r += NGW) p0_transpose_item<true>(F.in[22], DM, NUP, WUP, F.in[21], scr, r, F.lane);
    constexpr int I_DOWN_A = (I_DOWN * 5) / 8;
    if (which & 8) for (int r = gw; r < I_DOWN_A; r += NGW) p0_transpose_item<false>(F.in[25], DFF, DM, WDOWN, nullptr, scr, r, F.lane);
    if (which & 16) for (int r = I_DOWN_A + gw; r < I_DOWN; r += NGW) p0_transpose_item<false>(F.in[25], DFF, DM, WDOWN, nullptr, scr, r, F.lane);
}
__device__ __forceinline__ void p0_prologue(const Ctx& F) {
    const int gw = F.bid * NWAVES + F.wave, NGW = F.G * NWAVES;
    convert_weights(F, 1, F.bid, F.G);
    { unsigned* xz = (unsigned*)(F.ws + WS_XCH); const int gt = F.bid * NTHREADS + F.tid, NGT = F.G * NTHREADS;
      for (int i = gt; i < 64 * 256 * 8; i += NGT) __hip_atomic_store(xz + i, 0u, __ATOMIC_RELAXED, __HIP_MEMORY_SCOPE_AGENT); }
    { bf16_t* WG = (bf16_t*)(F.ws + WS_WG); const int gt = F.bid * NTHREADS + F.tid, NGT = F.G * NTHREADS;
      for (int idx = gt; idx < 16 * 128 * 64; idx += NGT) { const int blk = idx >> 13, n = (idx >> 6) & 127, k = idx & 63;
          const float v = (n < 64) ? F.in[11][(blk * 64 + k) * 64 + n] : F.in[13][(blk * 64 + k) * 64 + (n - 64)];
          WG[idx] = (bf16_t)(pk2(v, 0.f) & 0xffffu); } }
    if (gw == 0) { u32x4* z = (u32x4*)(F.ws + WS_XN - 2 * DM * 2);
#pragma unroll
        for (int j = 0; j < 8; ++j) z[F.lane + 64 * j] = (u32x4){0u, 0u, 0u, 0u}; }
    { bf16_t* XN = (bf16_t*)(F.ws + WS_XN); float* RSX = (float*)(F.ws + CT_RSTD_X);
      for (int m = gw; m < MT; m += NGW) {
          const float* xr = (m < MP) ? F.in[0] + (size_t)m * DM : F.in[1] + (size_t)(m - MP) * DM;
          f32x4 v[8]; float s = 0.f;
#pragma unroll
          for (int j = 0; j < 8; ++j) { v[j] = *(const f32x4*)(xr + 4 * (F.lane + 64 * j)); s += (v[j][0] * v[j][0] + v[j][1] * v[j][1]) + (v[j][2] * v[j][2] + v[j][3] * v[j][3]); }
#pragma unroll
          for (int j = 0; j < 8; ++j) { const f32x4 o = v[j];
              u32x2 w; w.x = pk2(o[0], o[1]); w.y = pk2(o[2], o[3]); *(u32x2*)(XN + (size_t)m * DM + 4 * (F.lane + 64 * j)) = w; }
          const float rstd = __builtin_amdgcn_rsqf(wave_sum(s) * (1.0f / DM) + EPS);
          if (F.lane == 0) RSX[m] = rstd; } }
}

__device__ __forceinline__ f32x4 ld_bf4(const bf16_t* p) { const u32x2 w = *(const u32x2*)p; return (f32x4){bflo(w.x), bfhi(w.x), bflo(w.y), bfhi(w.y)}; }
__device__ __forceinline__ void p2_copies(const Ctx& F, int part, int nparts) {
    const bf16_t* PROJ = (const bf16_t*)(F.ws + WS_PROJ);
    const int gt = part * NTHREADS + F.tid, NGT = nparts * NTHREADS;
    for (int base = gt; base < 2 * 128 * 128 * 64; base += 8 * NGT) {
        f32x4 v[8];
#pragma unroll
        for (int t = 0; t < 8; ++t) { const int idx = base + t * NGT; v[t] = (f32x4){0.f, 0.f, 0.f, 0.f};
            if (idx < 2 * 128 * 128 * 64) { const int kv = idx / (128 * 128 * 64), r = idx % (128 * 128 * 64), s = r / (128 * 64), w = (r / 64) % 128, c4 = r % 64;
                if (w < 124) v[t] = *(const f32x4*)(F.in[4 + kv] + ((size_t)(s * 128 + w + 4)) * 256 + 4 * c4);
                else v[t] = ld_bf4(PROJ + (size_t)(MP + 4 * s + (w - 124)) * NPROJ + (kv ? COL_V : COL_K) + 4 * c4); } }
#pragma unroll
        for (int t = 0; t < 8; ++t) { const int idx = base + t * NGT;
            if (idx < 2 * 128 * 128 * 64) { const int kv = idx / (128 * 128 * 64), r = idx % (128 * 128 * 64); *(f32x4*)(F.out + (kv ? O_S_WV : O_S_WK) + (size_t)r * 4) = v[t]; } }
    }
    for (int idx = gt; idx < 2 * 2 * 128 * 64; idx += NGT) {
        const int kv = idx / (2 * 128 * 64), r = idx % (2 * 128 * 64), b = r / (128 * 64), w = (r / 64) % 128, c4 = r % 64;
        *(f32x4*)(F.out + (kv ? O_P_WV : O_P_WK) + (size_t)r * 4) = ld_bf4(PROJ + (size_t)(b * SEQ + SEQ - 128 + w) * NPROJ + (kv ? COL_V : COL_K) + 4 * c4);
    }
    for (int idx = gt; idx < 2 * 3 * 256; idx += NGT) { const int b = idx / (3 * 256), j = (idx / 256) % 3, c4 = idx % 256;
        *(f32x4*)(F.out + O_P_RCONV + (size_t)idx * 4) = ld_bf4(PROJ + (size_t)(b * SEQ + SEQ - 3 + j) * NPROJ + COL_XR + 4 * c4); }
    for (int idx = gt; idx < 128 * 3 * 256; idx += NGT) { const int s = idx / (3 * 256), j = (idx / 256) % 3, c4 = idx % 256;
        *(f32x4*)(F.out + O_S_RCONV + (size_t)idx * 4) = ld_bf4(PROJ + (size_t)(MP + 4 * s + 1 + j) * NPROJ + COL_XR + 4 * c4); }
}

constexpr int R_WGL = 0, R_WAVE = 18432, R_WSTRIDE = 5120, R_XCBW = 2688, R_WT = 59392, R_PART = 67584, R_HIN = 75776, R_END = 77824;
template <int MODE>
__device__ __forceinline__ void rnn_phase(const Ctx& F, int n_units) {
    const bf16_t* PROJ = (const bf16_t*)(F.ws + WS_PROJ);
    const int tid = F.tid, lane = F.lane, w = F.wave, l15 = lane & 15, q = lane >> 4;
    LAS bf16_t* WGL = (LAS bf16_t*)(F.lds + R_WGL);
    LAS bf16_t* XBw = (LAS bf16_t*)(F.lds + R_WAVE + w * R_WSTRIDE); LAS bf16_t* XCBw = (LAS bf16_t*)(F.lds + R_WAVE + w * R_WSTRIDE + R_XCBW);
    LAS float* HINw = (LAS float*)(F.lds + R_HIN) + w * 64;
    int cur_blk = -1, par = 0;
    LDS_BARRIER();
    u32x4 n_vx[3], n_du[4]; u32x2 n_gv[4]; f32x2 n_sv[8];
#define RNN_DECODE(unit_, b_, c_, blk_, row0_) do { if (MODE == 2) { blk_ = (unit_) & 15; c_ = (unit_) >> 4; b_ = 0; row0_ = MP + 128 * c_; } \
        else { blk_ = (unit_) & 15; c_ = ((unit_) >> 4) & 63; b_ = (unit_) >> 10; row0_ = b_ * SEQ + 128 * c_; } } while (0)
#define RNN_LOADS(unit_) do { int b_, c_, blk_, row0_; RNN_DECODE(unit_, b_, c_, blk_, row0_); const int tk0_ = 16 * w + 4 * q, gch0_ = blk_ * 64 + 4 * l15; \
        if (MODE != 0) { const bf16_t* gp0 = PROJ + (size_t)(row0_ + tk0_) * NPROJ + COL_GR + gch0_; \
            _Pragma("unroll") for (int r = 0; r < 4; ++r) n_gv[r] = *(const u32x2*)(gp0 + (size_t)r * NPROJ); } \
        if (MODE == 1) { const unsigned* DUp = (const unsigned*)(F.ws + WS_DU) + (size_t)(row0_ + tk0_) * DRNN + gch0_; \
            _Pragma("unroll") for (int r = 0; r < 4; ++r) n_du[r] = *(const u32x4*)(DUp + (size_t)r * DRNN); \
            const float* SUMM = (const float*)(F.ws + WS_SUMM); \
            _Pragma("unroll") for (int kk = 0; kk < 8; ++kk) { const int k = 8 * w + kk, kc = (k < c_) ? k : 0; n_sv[kk] = *(const f32x2*)(SUMM + ((size_t)(b_ * 64 + kc) * 1024 + blk_ * 64 + lane) * 2); } } \
        else { _Pragma("unroll") for (int t = 0; t < 3; ++t) { const int id = lane + 64 * t, i = id >> 3, ch = id & 7; n_vx[t] = (u32x4){0u, 0u, 0u, 0u}; \
                const int cr = 16 * w - 3 + i; const bool ok = (id < 19 * 8) && ((MODE == 2) ? (cr >= 0) : (c_ > 0 || cr >= 0)); \
                if (ok) n_vx[t] = *(const u32x4*)(PROJ + (size_t)(row0_ + cr) * NPROJ + COL_XR + blk_ * 64 + ch * 8); } } } while (0)
    f32x4 cw0 = {0.f, 0.f, 0.f, 0.f}, cw1 = cw0, cw2 = cw0, cw3 = cw0, cbv = cw0, ba4 = cw0, bx4 = cw0, lam4 = cw0, c8v = cw0;
    if (F.bid < n_units) RNN_LOADS(F.bid);
    for (int unit = F.bid; unit < n_units; unit += F.G, par ^= 1) {
        int b = 0, c = 0, blk, row0;
        RNN_DECODE(unit, b, c, blk, row0);
        LAS float* WT = (LAS float*)(F.lds + R_WT) + par * 1024; LAS float* PART = (LAS float*)(F.lds + R_PART) + par * 1024;
        if (MODE != 1 && blk != cur_blk) {
            if (cur_blk >= 0) LDS_BARRIER();
            const bf16_t* WG = (const bf16_t*)(F.ws + WS_WG) + (size_t)blk * 8192;
#pragma unroll
            for (int t = 0; t < 2; ++t) { const int id = tid + NTHREADS * t, np = id >> 3, ch = id & 7, j = np >> 4, l = np & 15, n = 64 * (j >> 2) + 4 * l + (j & 3);
                *(LAS u32x4*)(WGL + np * 72 + ch * 8) = *(const u32x4*)(WG + n * 64 + ch * 8); }
            { const int g0 = blk * 64 + 4 * l15;
              cw0 = *(const f32x4*)(F.in[9] + g0); cw1 = *(const f32x4*)(F.in[9] + 1024 + g0); cw2 = *(const f32x4*)(F.in[9] + 2048 + g0); cw3 = *(const f32x4*)(F.in[9] + 3072 + g0);
              cbv = *(const f32x4*)(F.in[10] + g0); ba4 = *(const f32x4*)(F.in[12] + g0); bx4 = *(const f32x4*)(F.in[14] + g0); lam4 = *(const f32x4*)(F.in[15] + g0);
#pragma unroll
              for (int jj = 0; jj < 4; ++jj) { const float lam = lam4[jj]; c8v[jj] = (8.0f * 1.4426950408889634f) * ((lam < -15.f) ? -lam : __logf(1.0f + __expf(-lam))); } }
            LDS_BARRIER(); cur_blk = blk;
        }
        const int tk0 = 16 * w + 4 * q, gch0 = blk * 64 + 4 * l15;
        unsigned* DU = (unsigned*)(F.ws + WS_DU) + (size_t)(row0 + tk0) * DRNN + gch0;
        float av[4][4], uv[4][4], P4[4], H4[4];
        u32x4 vx[3], du4[4]; u32x2 gvv[4]; f32x2 sv[8];
#pragma unroll
        for (int r = 0; r < 4; ++r) { gvv[r] = n_gv[r]; du4[r] = n_du[r]; }
#pragma unroll
        for (int t = 0; t < 3; ++t) vx[t] = n_vx[t];
#pragma unroll
        for (int kk = 0; kk < 8; ++kk) sv[kk] = n_sv[kk];
        if (unit + F.G < n_units) RNN_LOADS(unit + F.G);
        if (MODE == 1) {
            float P = 1.f, H = 0.f;
#pragma unroll
            for (int kk = 0; kk < 8; ++kk) { const int k = 8 * w + kk; if (k < c) { H = H * sv[kk].x + sv[kk].y; P = P * sv[kk].x; } }
            PART[(w * 64 + lane) * 2] = P; PART[(w * 64 + lane) * 2 + 1] = H;
#pragma unroll
            for (int jj = 0; jj < 4; ++jj) { float Pj = 1.f, Hj = 0.f;
#pragma unroll
                for (int r = 0; r < 4; ++r) { const float a = 1.0f - bflo(du4[r][jj]), u = bfhi(du4[r][jj]); av[jj][r] = a; uv[jj][r] = u; Hj = Hj * a + u; Pj = Pj * a; }
                P4[jj] = Pj; H4[jj] = Hj; }
        } else {
#pragma unroll
        for (int t = 0; t < 3; ++t) { const int id = lane + 64 * t, i = id >> 3, ch = id & 7;
            if (id < 19 * 8) { *(LAS u32x2*)(XBw + i * 68 + ch * 8) = (u32x2){vx[t].x, vx[t].y}; *(LAS u32x2*)(XBw + i * 68 + ch * 8 + 4) = (u32x2){vx[t].z, vx[t].w}; } }
        LDS_WAIT();
        f32x4 xin[7];
#pragma unroll
        for (int j = 0; j < 7; ++j) { const u32x2 p = *(const LAS u32x2*)(XBw + (4 * q + j) * 68 + 4 * l15); xin[j] = (f32x4){bflo(p.x), bfhi(p.x), bflo(p.y), bfhi(p.y)}; }
        if (MODE == 2) { const int sq = (row0 - MP) / 4 + 4 * w + q;
#pragma unroll
            for (int j = 0; j < 3; ++j) xin[j] = *(const f32x4*)(F.in[2] + ((size_t)sq * 3 + j) * 1024 + gch0); }
        f32x4 xc[4];
#pragma unroll
        for (int r = 0; r < 4; ++r) { xc[r] = cbv + cw0 * xin[r] + cw1 * xin[r + 1] + cw2 * xin[r + 2] + cw3 * xin[r + 3];
            *(LAS u32x2*)(XCBw + (4 * q + r) * 72 + 4 * l15) = (u32x2){pk2(xc[r][0], xc[r][1]), pk2(xc[r][2], xc[r][3])}; }
        LDS_WAIT();
        f32x4 ga[8];
#pragma unroll
        for (int j = 0; j < 8; ++j) ga[j] = (f32x4){0.f, 0.f, 0.f, 0.f};
#pragma unroll
        for (int ks = 0; ks < 2; ++ks) { const bf16x8 af = *(const LAS bf16x8*)(XCBw + l15 * 72 + 32 * ks + 8 * q);
#pragma unroll
            for (int j = 0; j < 8; ++j) { const bf16x8 bfr = *(const LAS bf16x8*)(WGL + (16 * j + l15) * 72 + 32 * ks + 8 * q);
                ga[j] = __builtin_amdgcn_mfma_f32_16x16x32_bf16(af, bfr, ga[j], 0, 0, 0); } }
        u32x4 pw4[4];
#pragma unroll
        for (int jj = 0; jj < 4; ++jj) { const float ba = ba4[jj], bx = bx4[jj];
            const float c8 = c8v[jj];
            const f32x4 ta = (ga[jj] + ba) * (-1.4426950408889634f), tx = (ga[4 + jj] + bx) * (-1.4426950408889634f);
            f32x4 ea, ex;
#pragma unroll
            for (int r = 0; r < 4; ++r) { ea[r] = __builtin_amdgcn_exp2f(ta[r]); ex[r] = __builtin_amdgcn_exp2f(tx[r]); }
            ea = ea + 1.0f; ex = ex + 1.0f;
            const f32x4 den = ea * ex; f32x4 rc;
#pragma unroll
            for (int r = 0; r < 4; ++r) rc[r] = __builtin_amdgcn_rcpf(den[r]);
            const f32x4 rr = ex * rc, ii = ea * rc, la = rr * (-c8);
            f32x4 a4;
#pragma unroll
            for (int r = 0; r < 4; ++r) a4[r] = __builtin_amdgcn_exp2f(la[r]);
            f32x4 om = 1.0f - a4 * a4, sq;
#pragma unroll
            for (int r = 0; r < 4; ++r) sq[r] = __builtin_amdgcn_sqrtf(fmaxf(om[r], 0.f));
            const f32x4 xcj = {xc[0][jj], xc[1][jj], xc[2][jj], xc[3][jj]};
            f32x4 u4 = sq * (ii * xcj);
            if (MODE == 0) {
#pragma unroll
                for (int r = 0; r < 4; ++r) { const unsigned pw = pk2(1.0f - a4[r], u4[r]); pw4[r][jj] = pw; a4[r] = 1.0f - bflo(pw); u4[r] = bfhi(pw); } }
            float P = 1.f, H = 0.f;
#pragma unroll
            for (int r = 0; r < 4; ++r) { av[jj][r] = a4[r]; uv[jj][r] = u4[r]; H = H * a4[r] + u4[r]; P = P * a4[r]; }
            P4[jj] = P; H4[jj] = H; }
        if (MODE == 0) {
#pragma unroll
            for (int r = 0; r < 4; ++r) *(u32x4*)(DU + (size_t)r * DRNN) = pw4[r]; }
        }
        LAS bf16_t* YBw = XBw;
        if (MODE == 2) {
            const int sq = (row0 - MP) / 4 + 4 * w + q;
            const f32x4 h0 = *(const f32x4*)(F.in[3] + (size_t)sq * 1024 + gch0);
            float ssq[4] = {0.f, 0.f, 0.f, 0.f}; f32x4 hfin; float yv[4][4];
#pragma unroll
            for (int jj = 0; jj < 4; ++jj) { float h = h0[jj];
#pragma unroll
                for (int r = 0; r < 4; ++r) { h = av[jj][r] * h + uv[jj][r];
                    const float g = (jj & 1) ? bfhi(jj < 2 ? gvv[r].x : gvv[r].y) : bflo(jj < 2 ? gvv[r].x : gvv[r].y);
                    const float y = gelu_tanh(g) * h; yv[r][jj] = y; ssq[r] += y * y; }
                hfin[jj] = h; }
            *(f32x4*)(F.out + O_S_RH + (size_t)sq * 1024 + gch0) = hfin;
#pragma unroll
            for (int r = 0; r < 4; ++r) { *(LAS u32x2*)(YBw + (4 * q + r) * 68 + 4 * l15) = (u32x2){pk2(yv[r][0], yv[r][1]), pk2(yv[r][2], yv[r][3])};
                float s = ssq[r]; s += __shfl_xor(s, 1); s += __shfl_xor(s, 2); s += __shfl_xor(s, 4); s += __shfl_xor(s, 8);
                if (l15 == 0) atomicAdd((float*)(F.ws + CT_SS_RNN) + row0 + tk0 + r, s); }
        } else {
            float E_P[4], E_H[4], T_P[4], T_H[4];
#pragma unroll
            for (int jj = 0; jj < 4; ++jj) { float eP = 1.f, eH = 0.f, tP = 1.f, tH = 0.f;
#pragma unroll
                for (int g = 0; g < 4; ++g) { const float pg = __shfl(P4[jj], l15 + 16 * g), hg = __shfl(H4[jj], l15 + 16 * g);
                    if (g < q) { eH = eH * pg + hg; eP = eP * pg; }
                    tH = tH * pg + hg; tP = tP * pg; }
                E_P[jj] = eP; E_H[jj] = eH; T_P[jj] = tP; T_H[jj] = tH; }
            if (q == 0) { LAS float* wt = WT + (w * 64 + 4 * l15) * 2;
                *(LAS f32x4*)wt = (f32x4){T_P[0], T_H[0], T_P[1], T_H[1]}; *(LAS f32x4*)(wt + 4) = (f32x4){T_P[2], T_H[2], T_P[3], T_H[3]}; }
            LDS_BARRIER();
            if (MODE == 0) {
                if (tid < 64) { float P = 1.f, H = 0.f;
#pragma unroll
                    for (int p = 0; p < 8; ++p) { const float pp = WT[(p * 64 + tid) * 2], hh = WT[(p * 64 + tid) * 2 + 1]; H = H * pp + hh; P = P * pp; }
                    float* SUMM = (float*)(F.ws + WS_SUMM); *(f32x2*)(SUMM + ((size_t)(b * 64 + c) * 1024 + blk * 64 + tid) * 2) = (f32x2){P, H}; }
            } else {
                { float h = 0.f; float pp[8], ph[8], wp[7], wh[7];
#pragma unroll
                  for (int p = 0; p < 8; ++p) { pp[p] = PART[(p * 64 + lane) * 2]; ph[p] = PART[(p * 64 + lane) * 2 + 1]; }
#pragma unroll
                  for (int p = 0; p < 7; ++p) { wp[p] = WT[(p * 64 + lane) * 2]; wh[p] = WT[(p * 64 + lane) * 2 + 1]; }
#pragma unroll
                  for (int p = 0; p < 8; ++p) h = h * pp[p] + ph[p];
#pragma unroll
                  for (int p = 0; p < 7; ++p) if (p < w) h = h * wp[p] + wh[p];
                  HINw[lane] = h; }
                LDS_WAIT();
                const f32x4 hin = *(const LAS f32x4*)(HINw + 4 * l15);
                float ssq[4] = {0.f, 0.f, 0.f, 0.f}; f32x4 hfin; float yv[4][4];
#pragma unroll
                for (int jj = 0; jj < 4; ++jj) { float h = hin[jj] * E_P[jj] + E_H[jj];
#pragma unroll
                    for (int r = 0; r < 4; ++r) { h = av[jj][r] * h + uv[jj][r];
                        const float g = (jj & 1) ? bfhi(jj < 2 ? gvv[r].x : gvv[r].y) : bflo(jj < 2 ? gvv[r].x : gvv[r].y);
                        const float y = gelu_tanh(g) * h; yv[r][jj] = y; ssq[r] += y * y; }
                    hfin[jj] = h; }
                if (c == 63 && w == 7 && q == 3) *(f32x4*)(F.out + O_P_RH + (size_t)b * 1024 + gch0) = hfin;
#pragma unroll
                for (int r = 0; r < 4; ++r) { *(LAS u32x2*)(YBw + (4 * q + r) * 68 + 4 * l15) = (u32x2){pk2(yv[r][0], yv[r][1]), pk2(yv[r][2], yv[r][3])};
                    float s = ssq[r]; s += __shfl_xor(s, 1); s += __shfl_xor(s, 2); s += __shfl_xor(s, 4); s += __shfl_xor(s, 8);
                    if (l15 == 0) atomicAdd((float*)(F.ws + CT_SS_RNN) + row0 + tk0 + r, s); }
            }
        }
        if (MODE != 0) {
            LDS_WAIT();
#pragma unroll
            for (int t = 0; t < 2; ++t) { const int id = lane + 64 * t, i = id >> 3, ch = id & 7;
                const u32x2 a = *(const LAS u32x2*)(YBw + i * 68 + ch * 8), b2 = *(const LAS u32x2*)(YBw + i * 68 + ch * 8 + 4);
                *(u32x4*)((bf16_t*)(F.ws + WS_MERGED) + (size_t)(row0 + 16 * w + i) * DM + blk * 64 + ch * 8) = (u32x4){a.x, a.y, b2.x, b2.y}; }
            LDS_WAIT();
        }
    }
}

#undef RNN_LOADS
#undef RNN_DECODE
__device__ __forceinline__ int t5_bucket(int n) {
    if (n < 16) return n;
    int l = 16 + (int)(__logf((float)n * (1.0f / 16.0f)) * (16.0f / 2.0794415416798357f));
    return l < 31 ? l : 31;
}
constexpr int A_KL = 0, A_VT = 36864, A_BIAS = 70656, A_END = 81152;
__device__ __forceinline__ void attn_prompt_unit(const Ctx& F, int unit, bool first) {
    const bf16_t* PROJ = (const bf16_t*)(F.ws + WS_PROJ);
    const int tid = F.tid, lane = F.lane, w = F.wave, l15 = lane & 15, q = lane >> 4;
    const int kvh = unit & 3, qb = (unit >> 2) & 63, b = unit >> 8;
    LAS bf16_t* KL = (LAS bf16_t*)(F.lds + A_KL); LAS bf16_t* VT = (LAS bf16_t*)(F.lds + A_VT); LAS float* BIAS = (LAS float*)(F.lds + A_BIAS);
    LAS float* TB = (LAS float*)(F.lds + A_END);
    LDS_BARRIER();
    float tbv = 0.f;
    if (first && tid < 128) tbv = F.in[17][(tid >> 2) * 16 + 4 * kvh + (tid & 3)] * 1.4426950408889634f;
    const int kb0 = qb * 128 - 128;
#pragma unroll
    for (int i = 0; i < 4; ++i) { const int id = tid + NTHREADS * i, r = id >> 3, ch = id & 7; const int t = kb0 + r;
        u32x4 v = {0u, 0u, 0u, 0u};
        if (t >= 0) v = *(const u32x4*)(PROJ + (size_t)(b * SEQ + t) * NPROJ + COL_K + kvh * 64 + ch * 8);
        *(LAS u32x4*)(KL + r * 72 + ch * 8) = v; }
#pragma unroll
    for (int i = 0; i < 4; ++i) { const int id = tid + NTHREADS * i, key = id & 255, ch = id >> 8; const int t = kb0 + key;
        u32x4 v = {0u, 0u, 0u, 0u};
        if (t >= 0) v = *(const u32x4*)(PROJ + (size_t)(b * SEQ + t) * NPROJ + COL_V + kvh * 64 + ch * 8);
        LAS bf16_t* d = VT + (ch * 8) * 264 + key;
        d[0 * 264] = (bf16_t)(v.x & 0xffffu); d[1 * 264] = (bf16_t)(v.x >> 16); d[2 * 264] = (bf16_t)(v.y & 0xffffu); d[3 * 264] = (bf16_t)(v.y >> 16);
        d[4 * 264] = (bf16_t)(v.z & 0xffffu); d[5 * 264] = (bf16_t)(v.z >> 16); d[6 * 264] = (bf16_t)(v.w & 0xffffu); d[7 * 264] = (bf16_t)(v.w >> 16); }
    if (first) {
        if (tid < 128) TB[tid] = tbv;
        LDS_BARRIER();
        for (int id = tid; id < 4 * 4 * 164; id += NTHREADS) { const int cp = id / 656, g = (id / 164) & 3, k = id % 164, d = 144 + cp - k;
            BIAS[id] = (d >= 0 && d < 128) ? TB[t5_bucket(d) * 4 + g] : -1e30f; } }
    LDS_BARRIER();
    const int i_q = 16 * w + l15;
    const int qrow = b * SEQ + qb * 128 + i_q;
    bf16x8 qfa[4][2];
#pragma unroll
    for (int g = 0; g < 4; ++g) { qfa[g][0] = *(const bf16x8*)(PROJ + (size_t)qrow * NPROJ + COL_Q + (4 * kvh + g) * 64 + 8 * q); qfa[g][1] = *(const bf16x8*)(PROJ + (size_t)qrow * NPROJ + COL_Q + (4 * kvh + g) * 64 + 32 + 8 * q); }
#pragma unroll
    for (int g = 0; g < 4; ++g) {
        const int head = 4 * kvh + g;
        const bf16x8 qf0 = qfa[g][0], qf1 = qfa[g][1];
        f32x4 sc[10];
#pragma unroll
        for (int jj = 0; jj < 9; ++jj) { const int j = w + jj; sc[jj] = (f32x4){0.f, 0.f, 0.f, 0.f};
            const bf16x8 k0 = *(const LAS bf16x8*)(KL + (16 * j + l15) * 72 + 8 * q), k1 = *(const LAS bf16x8*)(KL + (16 * j + l15) * 72 + 32 + 8 * q);
            sc[jj] = __builtin_amdgcn_mfma_f32_16x16x32_bf16(k0, qf0, sc[jj], 0, 0, 0); sc[jj] = __builtin_amdgcn_mfma_f32_16x16x32_bf16(k1, qf1, sc[jj], 0, 0, 0);
            if (jj & 1) asm volatile("" ::: "memory"); }
        sc[9] = (f32x4){0.f, 0.f, 0.f, 0.f};
        const float sink = F.in[16][head] * 1.4426950408889634f;
        const LAS float* bt = BIAS + ((l15 & 3) * 4 + g) * 164 + (144 + (l15 & 3) - (128 + i_q - 16 * w - 4 * q));
        float mx = sink;
#pragma unroll
        for (int jj = 0; jj < 9; ++jj) { f32x4 s4 = sc[jj] * (0.125f * 1.4426950408889634f) + *(const LAS f32x4*)(bt + 16 * jj);
            if (qb == 0) {
#pragma unroll
                for (int r = 0; r < 4; ++r) { const int jk = 16 * (w + jj) + 4 * q + r; s4[r] = (jk >= 128) ? s4[r] : -1e30f; } }
            sc[jj] = s4; mx = fmaxf(fmaxf(mx, fmaxf(s4[0], s4[1])), fmaxf(s4[2], s4[3])); }
        mx = fmaxf(mx, __shfl_xor(mx, 16)); mx = fmaxf(mx, __shfl_xor(mx, 32));
        f32x4 l4 = {0.f, 0.f, 0.f, 0.f};
#pragma unroll
        for (int jj = 0; jj < 9; ++jj) { const f32x4 d4 = sc[jj] - mx; f32x4 p4;
            p4[0] = __builtin_amdgcn_exp2f(d4[0]); p4[1] = __builtin_amdgcn_exp2f(d4[1]); p4[2] = __builtin_amdgcn_exp2f(d4[2]); p4[3] = __builtin_amdgcn_exp2f(d4[3]);
            sc[jj] = p4; l4 = l4 + p4; }
        float l = (l4[0] + l4[1]) + (l4[2] + l4[3]);
        l += __shfl_xor(l, 16); l += __shfl_xor(l, 32);
        const float inv = __builtin_amdgcn_rcpf(l + __builtin_amdgcn_exp2f(sink - mx));
        f32x4 o[4];
#pragma unroll
        for (int dt = 0; dt < 4; ++dt) o[dt] = (f32x4){0.f, 0.f, 0.f, 0.f};
#pragma unroll
        for (int pp = 0; pp < 5; ++pp) {
            u32x4 pw; pw.x = pk2(sc[2 * pp][0], sc[2 * pp][1]); pw.y = pk2(sc[2 * pp][2], sc[2 * pp][3]); pw.z = pk2(sc[2 * pp + 1][0], sc[2 * pp + 1][1]); pw.w = pk2(sc[2 * pp + 1][2], sc[2 * pp + 1][3]);
            const bf16x8 pf = __builtin_bit_cast(bf16x8, pw);
            const int j0 = w + 2 * pp; int j1 = j0 + 1; if (j1 > 15) j1 = 15;
#pragma unroll
            for (int dt = 0; dt < 4; ++dt) { const LAS bf16_t* vr = VT + (16 * dt + l15) * 264;
                const u32x2 a0 = *(const LAS u32x2*)(vr + 16 * j0 + 4 * q), a1 = *(const LAS u32x2*)(vr + 16 * j1 + 4 * q);
                const bf16x8 vf = __builtin_bit_cast(bf16x8, (u32x4){a0.x, a0.y, a1.x, a1.y});
                o[dt] = __builtin_amdgcn_mfma_f32_16x16x32_bf16(vf, pf, o[dt], 0, 0, 0); }
            asm volatile("" ::: "memory"); }
        float ssq = 0.f;
        bf16_t* yo = (bf16_t*)(F.ws + WS_MERGED) + (size_t)qrow * DM + DRNN + head * 64 + 4 * q;
#pragma unroll
        for (int dt = 0; dt < 4; ++dt) { const f32x4 v = o[dt] * inv; ssq += (v[0] * v[0] + v[1] * v[1]) + (v[2] * v[2] + v[3] * v[3]);
            u32x2 wv; wv.x = pk2(v[0], v[1]); wv.y = pk2(v[2], v[3]); *(u32x2*)(yo + 16 * dt) = wv; }
        ssq += __shfl_xor(ssq, 16); ssq += __shfl_xor(ssq, 32);
        if (q == 0) atomicAdd((float*)(F.ws + CT_SS_ATT) + qrow, ssq);
    }
}
constexpr int AS_PW = 0, AS_BIAS = 24576, AS_RED = 45056, AS_TB = 77824;
__device__ __forceinline__ void attn_sample_unit(const Ctx& F, int unit) {
    const bf16_t* PROJ = (const bf16_t*)(F.ws + WS_PROJ);
    const int lane = F.lane, w = F.wave, l15 = lane & 15, q = lane >> 4;
    const int task = w >> 2, part = w & 3;
    const int wu = unit * 2 + task, s = wu >> 2, kvh = wu & 3;
    LAS float* PW = (LAS float*)(F.lds + AS_PW + w * 3072);
    LAS float* RED = (LAS float*)(F.lds + AS_RED + task * 16384);
    LDS_BARRIER();
    const int g = l15 >> 2, qi = l15 & 3, head = 4 * kvh + g;
    const size_t qrow = (size_t)(MP + 4 * s + qi);
    const bf16x8 qf0 = *(const bf16x8*)(PROJ + qrow * NPROJ + COL_Q + head * 64 + 8 * q);
    const bf16x8 qf1 = *(const bf16x8*)(PROJ + qrow * NPROJ + COL_Q + head * 64 + 32 + 8 * q);
    const float tb0 = F.in[17][(lane >> 2) * 16 + 4 * kvh + (lane & 3)], tb1 = F.in[17][(16 + (lane >> 2)) * 16 + 4 * kvh + (lane & 3)];
    f32x4 sc[9];
#pragma unroll
    for (int j = 0; j < 8; ++j) { const int kk = 16 * j + l15; sc[j] = (f32x4){0.f, 0.f, 0.f, 0.f};
        const float* kp = F.in[4] + ((size_t)(s * 128 + kk) * 4 + kvh) * 64 + 8 * q;
        const f32x4 a = *(const f32x4*)kp, bq = *(const f32x4*)(kp + 4), cq = *(const f32x4*)(kp + 32), dq = *(const f32x4*)(kp + 36);
        const bf16x8 k0 = __builtin_bit_cast(bf16x8, (u32x4){pk2(a[0], a[1]), pk2(a[2], a[3]), pk2(bq[0], bq[1]), pk2(bq[2], bq[3])});
        const bf16x8 k1 = __builtin_bit_cast(bf16x8, (u32x4){pk2(cq[0], cq[1]), pk2(cq[2], cq[3]), pk2(dq[0], dq[1]), pk2(dq[2], dq[3])});
        sc[j] = __builtin_amdgcn_mfma_f32_16x16x32_bf16(k0, qf0, sc[j], 0, 0, 0); sc[j] = __builtin_amdgcn_mfma_f32_16x16x32_bf16(k1, qf1, sc[j], 0, 0, 0);
        if (j % 3 == 2) asm volatile("" ::: "memory"); }
    {
        const bf16_t* kp = PROJ + (size_t)(MP + 4 * s + (l15 & 3)) * NPROJ + COL_K + kvh * 64 + 8 * q;
        u32x4 a = *(const u32x4*)kp, b2 = *(const u32x4*)(kp + 32);
        if (l15 >= 4) { a = (u32x4){0u, 0u, 0u, 0u}; b2 = a; }
        sc[8] = (f32x4){0.f, 0.f, 0.f, 0.f};
        sc[8] = __builtin_amdgcn_mfma_f32_16x16x32_bf16(__builtin_bit_cast(bf16x8, a), qf0, sc[8], 0, 0, 0); sc[8] = __builtin_amdgcn_mfma_f32_16x16x32_bf16(__builtin_bit_cast(bf16x8, b2), qf1, sc[8], 0, 0, 0); }
    const float sink = F.in[16][head] * 1.4426950408889634f;
    LAS float* BT = (LAS float*)(F.lds + AS_BIAS + w * 2560); LAS float* TB = (LAS float*)(F.lds + AS_TB + w * 512);
    TB[lane] = tb0 * 1.4426950408889634f; TB[64 + lane] = tb1 * 1.4426950408889634f;
    LDS_WAIT(); asm volatile("" ::: "memory");
    for (int id = lane; id < 640; id += 64) { const int gg = id / 160, d = id % 160 - 16; BT[id] = (d >= 0 && d < 128) ? TB[t5_bucket(d) * 4 + gg] : -1e30f; }
    LDS_WAIT(); asm volatile("" ::: "memory");
    float mx = sink;
#pragma unroll
    for (int j = 0; j < 9; ++j)
#pragma unroll
        for (int r = 0; r < 4; ++r) { const int key = 16 * j + 4 * q + r, dist = 128 + qi - key;
            const float sv = sc[j][r] * (0.125f * 1.4426950408889634f) + BT[g * 160 + dist + 16]; sc[j][r] = sv; mx = fmaxf(mx, sv); }
    mx = fmaxf(mx, __shfl_xor(mx, 16)); mx = fmaxf(mx, __shfl_xor(mx, 32));
    float l = 0.f;
#pragma unroll
    for (int j = 0; j < 9; ++j)
#pragma unroll
        for (int r = 0; r < 4; ++r) { const float p = __builtin_amdgcn_exp2f(sc[j][r] - mx); sc[j][r] = p; l += p; }
    l += __shfl_xor(l, 16); l += __shfl_xor(l, 32);
    const float inv = __builtin_amdgcn_rcpf(l + __builtin_amdgcn_exp2f(sink - mx));
#pragma unroll
    for (int j = 0; j < 8; ++j)
        if ((j >> 1) == part) {
#pragma unroll
            for (int r = 0; r < 4; ++r) PW[(16 * (j & 1) + 4 * q + r) * 16 + l15] = sc[j][r] * inv; }
    if (part == 3) {
#pragma unroll
        for (int r = 0; r < 4; ++r) PW[(32 + 4 * q + r) * 16 + l15] = sc[8][r] * inv; }
    LDS_WAIT(); asm volatile("" ::: "memory");
    float o[16];
#pragma unroll
    for (int i = 0; i < 16; ++i) o[i] = 0.f;
#pragma unroll 1
    for (int kb = 0; kb < 2; ++kb) { float vv[16];
#pragma unroll
      for (int j = 0; j < 16; ++j) vv[j] = F.in[5][((size_t)(s * 128 + 32 * part + 16 * kb + j) * 4 + kvh) * 64 + lane];
#pragma unroll
      for (int j = 0; j < 16; ++j) { const float v = vv[j]; const int key = 16 * kb + j;
          const f32x4 p0 = *(const LAS f32x4*)(PW + key * 16), p1 = *(const LAS f32x4*)(PW + key * 16 + 4), p2 = *(const LAS f32x4*)(PW + key * 16 + 8), p3 = *(const LAS f32x4*)(PW + key * 16 + 12);
#pragma unroll
          for (int e = 0; e < 4; ++e) { o[e] += p0[e] * v; o[4 + e] += p1[e] * v; o[8 + e] += p2[e] * v; o[12 + e] += p3[e] * v; } } }
    if (part == 3) { float vn[4];
#pragma unroll
      for (int j = 0; j < 4; ++j) vn[j] = bf2f(PROJ[(size_t)(MP + 4 * s + j) * NPROJ + COL_V + kvh * 64 + lane]);
#pragma unroll
      for (int j = 0; j < 4; ++j) { const int key = 32 + j; const float v = vn[j];
          const f32x4 p0 = *(const LAS f32x4*)(PW + key * 16), p1 = *(const LAS f32x4*)(PW + key * 16 + 4), p2 = *(const LAS f32x4*)(PW + key * 16 + 8), p3 = *(const LAS f32x4*)(PW + key * 16 + 12);
#pragma unroll
          for (int e = 0; e < 4; ++e) { o[e] += p0[e] * v; o[4 + e] += p1[e] * v; o[8 + e] += p2[e] * v; o[12 + e] += p3[e] * v; } } }
#pragma unroll
    for (int i = 0; i < 16; ++i) RED[(part * 16 + i) * 64 + lane] = o[i];
    LDS_BARRIER();
#pragma unroll
    for (int qq = 0; qq < 4; ++qq) { const int i = part * 4 + qq;
        const float t = (RED[(0 * 16 + i) * 64 + lane] + RED[(1 * 16 + i) * 64 + lane]) + (RED[(2 * 16 + i) * 64 + lane] + RED[(3 * 16 + i) * 64 + lane]);
        ((bf16_t*)(F.ws + WS_MERGED))[(size_t)(MP + 4 * s + qq) * DM + DRNN + (4 * kvh + part) * 64 + lane] = (bf16_t)(pk2(t, 0.f) & 0xffffu);
        const float t2 = wave_sum(t * t); if (lane == 0) atomicAdd((float*)(F.ws + CT_SS_ATT) + MP + 4 * s + qq, t2); }
}

__device__ __forceinline__ void p7_final(const Ctx& F) {
    const float* g = F.in[26]; const float* slab = (const float*)(F.ws + WS_SLAB); const bf16_t* HB = (const bf16_t*)(F.ws + WS_XN); LAS float* red = (LAS float*)F.lds;
    for (int m0 = 2 * F.bid; m0 < MS; m0 += 2 * F.G) { const int m = m0 + (F.wave >> 2), qd = F.wave & 3; float* yr = F.out + (size_t)(MP + m) * DM;
        f32x4 v[2];
#pragma unroll
        for (int j = 0; j < 2; ++j) v[j] = ld_bf4(HB + (size_t)(MP + m) * DM + 512 * qd + 4 * (F.lane + 64 * j));
#pragma unroll
        for (int sp0 = 0; sp0 < 16; sp0 += 8) { f32x4 t[8][2];
#pragma unroll
            for (int sp = 0; sp < 8; ++sp)
#pragma unroll
                for (int j = 0; j < 2; ++j) t[sp][j] = *(const f32x4*)(slab + ((size_t)(sp0 + sp) * MS + m) * DM + 512 * qd + 4 * (F.lane + 64 * j));
#pragma unroll
            for (int j = 0; j < 2; ++j) v[j] = v[j] + (((t[0][j] + t[1][j]) + (t[2][j] + t[3][j])) + ((t[4][j] + t[5][j]) + (t[6][j] + t[7][j]))); }
        float s = 0.f;
#pragma unroll
        for (int j = 0; j < 2; ++j) s += (v[j][0] * v[j][0] + v[j][1] * v[j][1]) + (v[j][2] * v[j][2] + v[j][3] * v[j][3]);
        s = wave_sum(s);
        LDS_BARRIER();
        if (F.lane == 0) red[F.wave] = s;
        LDS_BARRIER();
        const int w0 = F.wave & 4; const float rstd = __builtin_amdgcn_rsqf(((red[w0] + red[w0 + 1]) + (red[w0 + 2] + red[w0 + 3])) * (1.0f / DM) + EPS);
#pragma unroll
        for (int j = 0; j < 2; ++j) { const int cidx = 512 * qd + 4 * (F.lane + 64 * j); const f32x4 gg = *(const f32x4*)(g + cidx); *(f32x4*)(yr + cidx) = v[j] * rstd * gg; } }
}

__global__ void __launch_bounds__(NTHREADS, 2) hymba_fwd(Args args) {
    extern __shared__ __attribute__((aligned(16))) unsigned char lds_raw[];
    Ctx F; F.lds = (LAS unsigned char*)lds_raw; F.tid = threadIdx.x; F.lane = F.tid & 63; F.wave = __builtin_amdgcn_readfirstlane(F.tid >> 6);
    F.bid = blockIdx.x; F.G = gridDim.x; F.in = args.in; F.out = args.out; F.ws = args.ws;
    const int lo = args.ph_lo, hi = args.ph_hi;
    XcdBarrier bar; bar.bar = (unsigned*)(F.ws + CT_BAR); bar.x = 0; bar.st = (volatile LAS unsigned*)(F.lds + LDS_MISC);
    if (MK_N_LAUNCHES == 1) { if (F.tid < 64) ((LAS unsigned*)(F.lds + LDS_MISC))[F.tid] = 0u; __syncthreads(); bar = xcd_barrier_post((unsigned*)(F.ws + CT_BAR), (volatile LAS unsigned*)(F.lds + LDS_MISC)); }
#define IN(k) (lo <= (k) && (k) < hi)
#define RELAUNDER() do { int t_ = threadIdx.x; asm volatile("" : "+v"(t_)); F.tid = t_; F.lane = t_ & 63; } while (0)
#define GRIDBAR() do { if (MK_N_LAUNCHES == 1) xcd_barrier(bar); } while (0)
#define SEAM(k) do { if (IN(k) && IN((k) + 1)) { GRIDBAR(); } } while (0)
    bf16_t* XN = (bf16_t*)(F.ws + WS_XN); bf16_t* PROJ = (bf16_t*)(F.ws + WS_PROJ); bf16_t* MERGED = (bf16_t*)(F.ws + WS_MERGED); bf16_t* ACT = (bf16_t*)(F.ws + WS_ACT);
    float* SS_RNN = (float*)(F.ws + CT_SS_RNN); float* SS_ATT = (float*)(F.ws + CT_SS_ATT); float* SS_H = (float*)(F.ws + CT_SS_H);

    if (IN(0)) { RELAUNDER(); p0_prologue(F); }
    SEAM(0);
    if (IN(1)) { RELAUNDER(); gm::Order<0> S; S.init(MT / 256, NPROJ / 256, F.G, F.bid); gm::EpiProj E{PROJ, NPROJ, (const float*)(F.ws + CT_RSTD_X), (LAS float*)(F.lds + gm::STAGE_BYTES)};
        gm::gemm_phase(F.lds, XN, (const bf16_t*)(F.ws + WS_WIN), DM, DM / 64, S, E);
        { const int nfull = (MT / 256) * (NPROJ / 256) - 3 * F.G;
          if (F.G == 256 && F.bid >= nfull) convert_weights(F, 2 | 4, F.bid - nfull, F.G - nfull);
          else if (F.G != 256) convert_weights(F, 2 | 4, F.bid, F.G); } }
    SEAM(1);
    if (IN(2)) { RELAUNDER();
        rnn_phase<0>(F, 2048);
        if (MK_N_LAUNCHES == 1) split_arrive((unsigned*)(F.ws + CT_BAR2));
        for (int u = F.bid; u < 512; u += F.G) attn_prompt_unit(F, u, u == F.bid || (F.G & 3) != 0);
        for (int u = F.bid; u < 256; u += F.G) attn_sample_unit(F, u);
        if (F.G == 256) { if (F.bid < 64) rnn_phase<2>(F, 64); else p2_copies(F, F.bid - 64, F.G - 64); }
        else p2_copies(F, F.bid, F.G);
    }
    if (MK_N_LAUNCHES != 1) SEAM(2);
    if (IN(3)) { RELAUNDER();
        if (MK_N_LAUNCHES == 1) split_wait((unsigned*)(F.ws + CT_BAR2), (unsigned*)(F.ws + CT_BAR) + XB_TMO);
        rnn_phase<1>(F, 2048);
        if (F.G != 256) rnn_phase<2>(F, 64);
    }
    SEAM(3);
    if (IN(4)) { RELAUNDER();
        if (F.G != 256) convert_weights(F, 8, F.bid, F.G);
        __syncthreads();
        { gm::SplitOrder S; S.init(8, 256, F.G, F.bid); gm::EpiSlab<true> E{(float*)(F.ws + WS_SLAB), 256, SS_RNN, SS_ATT, (LAS float*)(F.lds + gm::STAGE_BYTES)};
          gm::gemm_phase(F.lds, MERGED, (const bf16_t*)(F.ws + WS_WOUT), DM, 4, S, E); }
        if (MK_N_LAUNCHES == 1 && F.G == 256 && F.bid < 128) split_arrive((unsigned*)(F.ws + CT_BAR3));
        { gm::Order<0> S; S.init(MP / 256, DM / 256, F.G, F.bid); gm::EpiH E{F.in[0], F.in[1], XN, SS_RNN, SS_ATT, SS_H, (LAS float*)(F.lds + gm::STAGE_BYTES)};
          gm::gemm_phase(F.lds, MERGED, (const bf16_t*)(F.ws + WS_WOUT), DM, DM / 64, S, E); }
        const bool fast4 = (MK_N_LAUNCHES == 1 && F.G == 256);
        int cpart = F.bid, cnparts = F.G; bool do_combine = true;
        if (fast4) { do_combine = F.bid >= 128; cpart = F.bid - 128; cnparts = 128;
            if (do_combine) split_wait((unsigned*)(F.ws + CT_BAR3), (unsigned*)(F.ws + CT_BAR) + XB_TMO, 128u); }
        else GRIDBAR();
        if (do_combine) { const float* slab = (const float*)(F.ws + WS_SLAB); LAS float* red = (LAS float*)F.lds;
          for (int m0 = 2 * cpart; m0 < MS; m0 += 2 * cnparts) { const int m = m0 + (F.wave >> 2), qd = F.wave & 3;
            f32x4 v[2], t[8][2];
#pragma unroll
            for (int j = 0; j < 2; ++j) { const int cidx = 512 * qd + 4 * (F.lane + 64 * j); v[j] = *(const f32x4*)(F.in[1] + (size_t)m * DM + cidx);
#pragma unroll
                for (int sp = 0; sp < 8; ++sp) t[sp][j] = *(const f32x4*)(slab + ((size_t)sp * MS + m) * DM + cidx); }
            float s = 0.f;
#pragma unroll
            for (int j = 0; j < 2; ++j) { const int cidx = 512 * qd + 4 * (F.lane + 64 * j);
                v[j] = v[j] + (((t[0][j] + t[1][j]) + (t[2][j] + t[3][j])) + ((t[4][j] + t[5][j]) + (t[6][j] + t[7][j])));
                u32x2 w; w.x = pk2(v[j][0], v[j][1]); w.y = pk2(v[j][2], v[j][3]); *(u32x2*)(XN + (size_t)(MP + m) * DM + cidx) = w;
                s += (v[j][0] * v[j][0] + v[j][1] * v[j][1]) + (v[j][2] * v[j][2] + v[j][3] * v[j][3]); }
            s = wave_sum(s);
            LDS_BARRIER();
            if (F.lane == 0) red[F.wave] = s;
            LDS_BARRIER();
            if (qd == 0 && F.lane == 0) SS_H[MP + m] = (red[F.wave] + red[F.wave + 1]) + (red[F.wave + 2] + red[F.wave + 3]); } }
        if (fast4) GRIDBAR();
        else if (MK_N_LAUNCHES == 1) split_arrive((unsigned*)(F.ws + CT_BAR3));
    }
    if (MK_N_LAUNCHES != 1) SEAM(4);
    if (IN(5)) { RELAUNDER();
        {
            { gm::Order<1> S; S.init(66, NUP / 256, F.G, F.bid); gm::EpiAct<false> E{ACT, SS_H, F.in[23], F.in[24], F.in[6], F.out + O_P_FFN, F.out + O_S_FFN, F.ws, (LAS float*)(F.lds + gm::STAGE_BYTES)};
              gm::gemm_phase(F.lds, XN, (const bf16_t*)(F.ws + WS_WUP), DM, DM / 64, S, E); }
            if (MK_N_LAUNCHES == 1 && F.G != 256) split_wait((unsigned*)(F.ws + CT_BAR3), (unsigned*)(F.ws + CT_BAR) + XB_TMO);
            { gm::Order<2> S; S.init(2, NUP / 256, F.G, (F.bid + F.G - 96 % F.G) % F.G); gm::EpiAct<true> E{ACT, SS_H, F.in[23], F.in[24], F.in[6], F.out + O_P_FFN, F.out + O_S_FFN, F.ws, (LAS float*)(F.lds + gm::STAGE_BYTES)};
              gm::gemm_phase(F.lds, XN, (const bf16_t*)(F.ws + WS_WUP), DM, DM / 64, S, E); }
        }
        if (F.G == 256 && F.bid >= 192) convert_weights(F, 8 | 16, F.bid - 192, 64);
        else if (F.G != 256) convert_weights(F, 16, F.bid, F.G);
    }
    SEAM(5);
    if (IN(6)) { RELAUNDER();
        { gm::Order<3> S; S.init(MP / 256, DM / 256, F.G, F.bid);
          gm::EpiOutNorm E{XN, F.out, F.in[26], (float*)(F.ws + WS_XCH), (unsigned*)(F.ws + CT_PCNT), (unsigned*)(F.ws + CT_BAR) + XB_TMO, (LAS float*)(F.lds + gm::STAGE_BYTES)};
          gm::gemm_phase(F.lds, ACT, (const bf16_t*)(F.ws + WS_WDOWN), DFF, DFF / 64, S, E); }
        { gm::SplitOrder S; S.init(16, 384, F.G, F.bid); gm::EpiSlab<false> E{(float*)(F.ws + WS_SLAB), 384, nullptr, nullptr, (LAS float*)(F.lds + gm::STAGE_BYTES)};
          gm::gemm_phase(F.lds, ACT, (const bf16_t*)(F.ws + WS_WDOWN), DFF, 6, S, E); }
    }
    SEAM(6);
    if (IN(7)) { RELAUNDER(); p7_final(F); }
#undef IN
#undef SEAM
}

extern "C" void kernel_launch(void* const* d_in, const int* in_sizes, int n_in, void* d_out, int out_size, void* d_ws, size_t ws_size, hipStream_t stream) {
    static int grid = 0;
    if (grid == 0) {
        if (n_in != 27 || out_size != (int)O_END || ws_size < WS_END) { fprintf(stderr, "kernel_launch: unexpected shapes (n_in %d out %d ws %zu)\n", n_in, out_size, ws_size); grid = -1; return; }
        int dev = 0, cus = 0, per_cu = 0;
        hipGetDevice(&dev); hipDeviceGetAttribute(&cus, hipDeviceAttributeMultiprocessorCount, dev);
        hipFuncSetAttribute((const void*)hymba_fwd, hipFuncAttributeMaxDynamicSharedMemorySize, LDS_BYTES);
        hipOccupancyMaxActiveBlocksPerMultiprocessor(&per_cu, (const void*)hymba_fwd, NTHREADS, LDS_BYTES);
        if (per_cu < 1) { fprintf(stderr, "kernel_launch: occupancy query says %d blocks per CU\n", per_cu); per_cu = 1; }
        (void)hipGetLastError();
        grid = cus;
    }
    if (grid < 0) return;
    hipMemsetAsync((char*)d_ws + WS_CTL, 0, CTL_BYTES, stream);
    Args a{};
    for (int i = 0; i < 27; ++i) a.in[i] = (const float*)d_in[i];
    a.out = (float*)d_out; a.ws = (unsigned char*)d_ws;
    if (MK_N_LAUNCHES == 1) {
        a.ph_lo = 0; a.ph_hi = 8;
        void* kargs[] = {&a};
        hipError_t e = hipLaunchCooperativeKernel((const void*)hymba_fwd, dim3(grid), dim3(NTHREADS), kargs, LDS_BYTES, stream);
        if (e != hipSuccess) fprintf(stderr, "kernel_launch: cooperative launch failed: %s (grid %d)\n", hipGetErrorString(e), grid);
    } else {
        for (int p = 0; p < 8; ++p) { a.ph_lo = p; a.ph_hi = p + 1; hipLaunchKernelGGL(hymba_fwd, dim3(grid), dim3(NTHREADS), LDS_BYTES, stream, a); }
    }
}
```

```cpp
#include <hip/hip_runtime.h>
#include <hip/hip_cooperative_groups.h>
#include <cstdint>
#include <cstdio>
namespace cg = cooperative_groups;

#ifndef MK_N_LAUNCHES
#define MK_N_LAUNCHES 1
#endif

#define LAS __attribute__((address_space(3)))
typedef unsigned short bf16_t;
typedef short bf16x8 __attribute__((ext_vector_type(8)));
typedef short s16x4 __attribute__((ext_vector_type(4)));
typedef float f32x4 __attribute__((ext_vector_type(4)));
typedef float f32x2 __attribute__((ext_vector_type(2)));
typedef unsigned u32x4 __attribute__((ext_vector_type(4)));
typedef unsigned u32x2 __attribute__((ext_vector_type(2)));
typedef __bf16 bf16x2_t __attribute__((ext_vector_type(2)));

constexpr int DM = 2048, SEQ = 8192, NB = 2, MP = NB * SEQ, NSEQ_S = 128, TS = 4, MS = NSEQ_S * TS, MT = MP + MS;
constexpr int DRNN = 1024, DATT = 1024, NPROJ = 3584, DFF = 6144, NUP = 12288, NHEAD = 16, KVH = 4, HD = 64;
constexpr int COL_XR = 0, COL_GR = 1024, COL_Q = 2048, COL_K = 3072, COL_V = 3328;
constexpr float EPS = 1e-6f;
constexpr int NTHREADS = 512, NWAVES = 8;
constexpr size_t O_Y = 0, O_P_RCONV = (size_t)MT * DM, O_P_RH = O_P_RCONV + 2 * 3 * 1024, O_P_WK = O_P_RH + 2 * 1024, O_P_WV = O_P_WK + 2 * 128 * 256,
                 O_P_FFN = O_P_WV + 2 * 128 * 256, O_S_RCONV = O_P_FFN + 2 * 2 * NUP, O_S_RH = O_S_RCONV + 128 * 3 * 1024, O_S_WK = O_S_RH + 128 * 1024,
                 O_S_WV = O_S_WK + (size_t)128 * 128 * 256, O_S_FFN = O_S_WV + (size_t)128 * 128 * 256, O_END = O_S_FFN + (size_t)128 * 2 * NUP;
static_assert(O_END == 46850048, "output size");
constexpr size_t MiB = 1u << 20;
constexpr size_t WS_CTL = 0, CTL_BYTES = 1 * MiB;
constexpr size_t CT_SS_RNN = 128 * 1024, CT_SS_ATT = 256 * 1024, CT_SS_H = 384 * 1024, CT_SS_OUT = 512 * 1024;
constexpr size_t CT_PCNT = 736 * 1024;
constexpr size_t CT_BAR3 = 724 * 1024;
constexpr size_t CT_RSTD_X = 512 * 1024;
constexpr size_t CT_BAR2 = 720 * 1024;
constexpr size_t CT_BAR = 640 * 1024;
constexpr size_t WS_WG = 1 * MiB;
constexpr size_t WS_XCH = 3 * MiB + 64 * 1024;
constexpr size_t WS_DUMP = 3 * MiB;
constexpr size_t WS_SUMM = 2 * MiB;
constexpr size_t WS_WIN = 4 * MiB, WS_WOUT = 18 * MiB, WS_WUP = 26 * MiB, WS_WDOWN = 74 * MiB;
constexpr size_t WS_XN = 100 * MiB;
constexpr size_t WS_PROJ = 168 * MiB;
constexpr size_t WS_MERGED = 284 * MiB;
constexpr size_t WS_ACT = 168 * MiB;
constexpr size_t WS_SLAB = 368 * MiB;
constexpr size_t WS_DU = WS_SLAB;
constexpr size_t WS_END = 432 * MiB;
static_assert(WS_ACT + (size_t)MT * DFF * 2 <= WS_END && WS_MERGED + (size_t)MT * DM * 2 <= WS_END && WS_PROJ + (size_t)MT * NPROJ * 2 <= WS_MERGED, "ws map");
constexpr int LDS_BYTES = 147456;
constexpr int LDS_MISC = LDS_BYTES - 256;

__device__ __forceinline__ unsigned pk2(float lo, float hi) { f32x2 v = {lo, hi}; bf16x2_t b = __builtin_convertvector(v, bf16x2_t); return __builtin_bit_cast(unsigned, b); }
__device__ __forceinline__ float bf2f(unsigned short h) { return __uint_as_float((unsigned)h << 16); }
__device__ __forceinline__ float bflo(unsigned w) { return __uint_as_float(w << 16); }
__device__ __forceinline__ float bfhi(unsigned w) { return __uint_as_float(w & 0xffff0000u); }
__device__ __forceinline__ float wave_sum(float v) {
#pragma unroll
    for (int o = 1; o < 64; o <<= 1) v += __shfl_xor(v, o);
    return v;
}
__device__ __forceinline__ float sigmoidf_(float x) { return __builtin_amdgcn_rcpf(1.0f + __builtin_amdgcn_exp2f(-1.4426950408889634f * x)); }
__device__ __forceinline__ float gelu_tanh(float x) {
    const float t = x * (2.3022082f + 0.1029432f * x * x);
    return x * __builtin_amdgcn_rcpf(1.0f + __builtin_amdgcn_exp2f(-t));
}
__device__ __forceinline__ f32x4 gelu_mul4(const f32x4 x, const f32x4 v) {
    const f32x4 t = x * (x * x * 0.1029432f + 2.3022082f);
    f32x4 e; e[0] = __builtin_amdgcn_exp2f(-t[0]); e[1] = __builtin_amdgcn_exp2f(-t[1]); e[2] = __builtin_amdgcn_exp2f(-t[2]); e[3] = __builtin_amdgcn_exp2f(-t[3]);
    const f32x4 d = e + 1.0f;
    f32x4 r; r[0] = __builtin_amdgcn_rcpf(d[0]); r[1] = __builtin_amdgcn_rcpf(d[1]); r[2] = __builtin_amdgcn_rcpf(d[2]); r[3] = __builtin_amdgcn_rcpf(d[3]);
    return (x * v) * r;
}
#define LDS_WAIT() asm volatile("s_waitcnt lgkmcnt(0)" ::: "memory")
#define LDS_BARRIER() do { asm volatile("s_waitcnt lgkmcnt(0)" ::: "memory"); __builtin_amdgcn_s_barrier(); asm volatile("" ::: "memory"); } while (0)

namespace gm {
constexpr unsigned XB_SPIN_CAP_ = 1u << 22;
constexpr int BM = 256, BK = 64, HALF = 128, HTB = HALF * BK * 2, STAGE_BYTES = 8 * HTB, NXCD = 8, WGM = 8;
__host__ __device__ __forceinline__ int lds_byte(int r, int c) { const int st = (r >> 4) * 2 + (c >> 5), rr = r & 15, cc = c & 31, ob = rr * 64 + cc * 2; return st * 1024 + (ob ^ (((ob >> 9) & 1) << 5)); }
__host__ __device__ __forceinline__ void stage_rc(int b, int& R, int& C) { const int st = b / 1024, sb = b % 1024, swz = sb ^ (((sb >> 9) & 1) << 5); R = (st >> 1) * 16 + swz / 64; C = (st & 1) * 32 + (swz % 64) / 2; }
__host__ __device__ __forceinline__ int perm32(int rho) { const int n = rho >> 4, i = rho & 15; return 8 * (i >> 2) + 4 * n + (i & 3); }

struct Unit { int pm, pn; int rowbase, seg; int k0; };
template <int ROWMODE> struct Order {
    int nM, nN, nwg, G, c;
    __device__ void init(int nM_, int nN_, int G_, int c_) { nM = nM_; nN = nN_; nwg = nM * nN; G = G_; c = c_; }
    __device__ bool next(int i, Unit& u) const {
        const long L = (long)i * G + c; if (L >= nwg) return false;
        int wgid = (int)L; { const int q = nwg / NXCD, r = nwg % NXCD, xcd = wgid % NXCD, off = wgid / NXCD; wgid = (xcd < r ? xcd * (q + 1) : r * (q + 1) + (xcd - r) * q) + off; }
        const int nig = WGM * nN, gid = wgid / nig, fm = gid * WGM, gsz = (nM - fm) < WGM ? (nM - fm) : WGM;
        if (ROWMODE == 3) { u.pm = fm + (wgid % nig) / nN; u.pn = (wgid % nig) % nN; }
        else { u.pm = fm + ((wgid % nig) % gsz); u.pn = (wgid % nig) / gsz; }
        u.k0 = 0;
        if (ROWMODE == 0 || ROWMODE == 3) { u.rowbase = u.pm * 256; u.seg = 128; }
        else if (ROWMODE == 1) { const int b = u.pm / 33, pmb = u.pm % 33; u.rowbase = b * SEQ + 252 * pmb - 2; u.seg = 126; }
        else { u.rowbase = MP + 256 * u.pm; u.seg = 128; }
        return true;
    }
};

struct SplitOrder {
    int KS, kper, G, c;
    __device__ void init(int KS_, int kper_, int G_, int c_) { KS = KS_; kper = kper_; G = G_; c = c_; }
    __device__ bool next(int i, Unit& u) const {
        const int L = i * G + c; if (L >= 16 * KS) return false;
        const int tile = L / KS, sp = L % KS;
        u.pm = 64 + (tile >> 3); u.pn = tile & 7; u.rowbase = 256 * u.pm; u.seg = 128; u.k0 = sp * kper; return true;
    }
};

template <class Epi, class Sched>
__device__ __forceinline__ void gemm_phase(LAS unsigned char* lds, const bf16_t* A, const bf16_t* Bt, const int K  , const int nt  , const Sched& S, const Epi& E) {
    const int tid = threadIdx.x, wid = __builtin_amdgcn_readfirstlane(tid >> 6), lane = tid & 63, wr = wid >> 2, wc = wid & 3, fr = lane & 15, fq = lane >> 4;
    unsigned voffA, voffB[2];
    { int R, C; stage_rc(tid * 16, R, C); voffA = (unsigned)(R * K + C) * 2u; }
#pragma unroll
    for (int i = 0; i < 2; ++i) { int R, C; stage_rc(tid * 16 + i * 8192, R, C); const int Rb = Epi::PERM ? ((R & ~31) + perm32(R & 31)) : R; voffB[i] = (unsigned)(Rb * K + C) * 2u; }
    const size_t kstep = (size_t)(BK * 2);
    const size_t hstepB = (size_t)HALF * K * 2, tstepB = 2 * hstepB;
    const size_t hstepA = (size_t)64 * K * 2, rowB = (size_t)K * 2;
    const unsigned ldsw = (unsigned)wid * 1024u;
    const int aoff = lds_byte(wr * 64 + fr, fq * 8), boff = lds_byte(wc * 32 + fr, fq * 8);
#define G_SA(b, h) (((b) * 2 + (h)) * HTB)
#define G_SB(b, h) ((4 + (b) * 2 + (h)) * HTB)
#define G_STAGEB(bufoff, gbase) do { _Pragma("unroll") for (int _i = 0; _i < 2; ++_i) \
        __builtin_amdgcn_global_load_lds((const unsigned*)((const char*)(gbase) + voffB[_i]), (LAS unsigned*)(lds + (bufoff) + ldsw + _i * 8192), 16, 0, 0); } while (0)
#define G_STAGEA(bufoff, gbase, segb) do { \
        __builtin_amdgcn_global_load_lds((const unsigned*)((const char*)(gbase) + voffA), (LAS unsigned*)(lds + (bufoff) + ldsw), 16, 0, 0); \
        __builtin_amdgcn_global_load_lds((const unsigned*)((const char*)(gbase) + (segb) + voffA), (LAS unsigned*)(lds + (bufoff) + ldsw + 8192), 16, 0, 0); } while (0)
#define G_LDA(dst, b, h) do { _Pragma("unroll") for (int m = 0; m < 4; ++m) _Pragma("unroll") for (int k = 0; k < 2; ++k) dst[m][k] = *(const LAS bf16x8*)(lds + G_SA(b, h) + aoff + m * 2048 + k * 1024); } while (0)
#define G_LDB(dst, b, h) do { _Pragma("unroll") for (int n = 0; n < 2; ++n) _Pragma("unroll") for (int k = 0; k < 2; ++k) dst[n][k] = *(const LAS bf16x8*)(lds + G_SB(b, h) + boff + n * 2048 + k * 1024); } while (0)
#define G_MMA(ai, bj, At, Bt_) do { __builtin_amdgcn_s_setprio(3); _Pragma("unroll") for (int m = 0; m < 4; ++m) _Pragma("unroll") for (int n = 0; n < 2; ++n) _Pragma("unroll") for (int k = 0; k < 2; ++k) \
        acc[ai][bj][m][n] = __builtin_amdgcn_mfma_f32_16x16x32_bf16(Bt_[n][k], At[m][k], acc[ai][bj][m][n], 0, 0, 0); __builtin_amdgcn_s_setprio(0); } while (0)
#define G_WAIT_V(n) asm volatile("s_waitcnt vmcnt(" #n ")" ::: "memory")
#define G_WAIT_L(n) asm volatile("s_waitcnt lgkmcnt(" #n ")" ::: "memory")
#define G_BAR __builtin_amdgcn_s_barrier()
#define G_SCHED __builtin_amdgcn_sched_barrier(0)
    Unit cur, nxt; int ui = 0;
    if (!S.next(0, cur)) return;
    f32x4 acc[2][2][4][2];
#pragma unroll
    for (int a = 0; a < 2; ++a)
#pragma unroll
        for (int b = 0; b < 2; ++b)
#pragma unroll
            for (int m = 0; m < 4; ++m)
#pragma unroll
                for (int n = 0; n < 2; ++n) acc[a][b][m][n] = (f32x4){0.f, 0.f, 0.f, 0.f};
    bf16x8 At[4][2], B0[2][2], B1[2][2];
    const char* cA = (const char*)A + (long)cur.rowbase * (long)rowB + (long)cur.k0 * 2; size_t cS = (size_t)cur.seg * rowB;
    const char* cB = (const char*)Bt + (size_t)cur.pn * tstepB + (size_t)cur.k0 * 2;
    E.pre(cur, wid, wr, lane);
    G_STAGEB(G_SB(0, 0), cB); G_STAGEB(G_SB(0, 1), cB + hstepB); G_STAGEA(G_SA(0, 0), cA, cS); G_STAGEA(G_SA(0, 1), cA + hstepA, cS);
    if (wr == 1) G_BAR;
    G_WAIT_V(2); G_BAR;
    G_STAGEB(G_SB(1, 0), cB + kstep); G_STAGEA(G_SA(1, 0), cA + kstep, cS); G_STAGEB(G_SB(1, 1), cB + hstepB + kstep);
    G_WAIT_V(6); G_BAR;
    for (;;) {
        const bool has_next = S.next(ui + 1, nxt);
        const char* nA = has_next ? (const char*)A + (long)nxt.rowbase * (long)rowB + (long)nxt.k0 * 2 : cA; const size_t nS = has_next ? (size_t)nxt.seg * rowB : cS;
        const char* nB = has_next ? (const char*)Bt + (size_t)nxt.pn * tstepB + (size_t)nxt.k0 * 2 : cB;
#pragma clang loop unroll(disable)
        for (int t = 0; t < nt; t += 2) {
            const bool last = (t == nt - 2);
            if constexpr (Epi::MID) { if (t == nt / 2) E.mid(acc, cur, wid, wr, fr); }
            const char* a1 = cA + (size_t)(t + 1) * kstep;
            const char* a2 = last ? nA : cA + (size_t)(t + 2) * kstep; const char* b2 = last ? nB : cB + (size_t)(t + 2) * kstep;
            const size_t s2 = last ? nS : cS;
            const char* a3 = a2 + kstep; const char* b3 = b2 + kstep;
            G_LDB(B0, 0, 0); G_LDB(B1, 0, 1); G_SCHED; G_LDA(At, 0, 0); G_STAGEA(G_SA(1, 1), a1 + hstepA, cS);
            G_WAIT_V(8); G_WAIT_L(0); G_BAR; G_MMA(0, 0, At, B0); G_MMA(0, 1, At, B1); G_BAR; G_SCHED;
            G_LDA(At, 0, 1); G_STAGEB(G_SB(0, 0), b2); G_STAGEB(G_SB(0, 1), b2 + hstepB); G_STAGEA(G_SA(0, 0), a2, s2);
            G_WAIT_V(8); G_WAIT_L(0); G_BAR; G_MMA(1, 0, At, B0); G_MMA(1, 1, At, B1); G_BAR; G_SCHED;
            G_LDB(B0, 1, 0); G_LDB(B1, 1, 1); G_SCHED; G_LDA(At, 1, 0); G_STAGEA(G_SA(0, 1), a2 + hstepA, s2);
            G_WAIT_V(8); G_WAIT_L(0); G_BAR; G_MMA(0, 0, At, B0); G_MMA(0, 1, At, B1); G_BAR; G_SCHED;
            G_LDA(At, 1, 1); G_STAGEB(G_SB(1, 0), b3); G_STAGEB(G_SB(1, 1), b3 + hstepB); G_STAGEA(G_SA(1, 0), a3, s2);
            G_WAIT_V(8); G_WAIT_L(0); G_BAR; G_MMA(1, 0, At, B0); G_MMA(1, 1, At, B1); G_BAR; G_SCHED;
        }
        if (wr == 0) G_BAR;
        { int fr_ = fr, fq_ = fq; asm volatile("" : "+v"(fr_), "+v"(fq_)); E(acc, cur, wid, wr, wc, fr_, fq_); }
        if (!has_next) break;
        E.pre(nxt, wid, wr, lane);
#pragma unroll
        for (int a = 0; a < 2; ++a)
#pragma unroll
            for (int b = 0; b < 2; ++b)
#pragma unroll
                for (int m = 0; m < 4; ++m)
#pragma unroll
                    for (int n = 0; n < 2; ++n) acc[a][b][m][n] = (f32x4){0.f, 0.f, 0.f, 0.f};
        cur = nxt; cA = nA; cS = nS; cB = nB; ++ui;
        if (wr == 1) G_BAR;
    }
    G_WAIT_V(0);
    G_BAR;
#undef G_SA
#undef G_SB
#undef G_STAGEA
#undef G_STAGEB
#undef G_LDA
#undef G_LDB
#undef G_MMA
#undef G_WAIT_V
#undef G_WAIT_L
#undef G_BAR
#undef G_SCHED
}

struct EpiProj {
    static constexpr bool PERM = true, MID = false;
    bf16_t* O; int ldc; const float* rsx; LAS float* tab;
    __device__ __forceinline__ void pre(const Unit& u, int wid, int wr, int lane) const {
        LAS float* T = tab + wid * 128;
#pragma unroll
        for (int k = 0; k < 2; ++k) __builtin_amdgcn_global_load_lds((const unsigned*)(rsx + u.rowbase + u.seg * wr + lane + 64 * k), (LAS unsigned*)(T + 64 * k), 4, 0, 0);
    }
    __device__ __forceinline__ void mid(f32x4 (&)[2][2][4][2], const Unit&, int, int, int) const {}
    __device__ __forceinline__ void operator()(f32x4 (&acc)[2][2][4][2], const Unit& u, int wid, int wr, int wc, int fr, int fq) const {
        const int row0 = u.rowbase + u.seg * wr + fr, col0 = u.pn * BM + wc * 32 + 8 * fq;
        const LAS float* T = tab + wid * 128;
        float rs[8];
#pragma unroll
        for (int g = 0; g < 8; ++g) rs[g] = T[(g >> 2) * 64 + (g & 3) * 16 + fr];
#pragma unroll
        for (int ai = 0; ai < 2; ++ai)
#pragma unroll
            for (int m = 0; m < 4; ++m) { bf16_t* rowp = O + (size_t)(row0 + ai * 64 + m * 16) * ldc + col0; const float f = rs[ai * 4 + m];
#pragma unroll
                for (int bj = 0; bj < 2; ++bj) { const f32x4 v0 = acc[ai][bj][m][0] * f, v1 = acc[ai][bj][m][1] * f;
                    u32x4 w; w.x = pk2(v0[0], v0[1]); w.y = pk2(v0[2], v0[3]); w.z = pk2(v1[0], v1[1]); w.w = pk2(v1[2], v1[3]);
                    *(u32x4*)(rowp + bj * HALF) = w; } }
    }
};
struct EpiH {
    static constexpr bool PERM = false, MID = true;
    const float* xp; const float* xs; bf16_t* HB; const float* ss_rnn; const float* ss_att; float* ss_h; LAS float* tab;
    __device__ __forceinline__ void pre(const Unit& u, int wid, int wr, int lane) const {
        LAS float* T = tab + wid * 256;
#pragma unroll
        for (int i = 0; i < 2; ++i) { const int s = lane + 64 * i, row = u.rowbase + u.seg * wr + s;
            const float sr = __builtin_amdgcn_rsqf(ss_rnn[row] * (1.0f / 1024.0f) + EPS), sa = __builtin_amdgcn_rsqf(ss_att[row] * (1.0f / 1024.0f) + EPS);
            T[s] = sr * __builtin_amdgcn_rcpf(sa); T[128 + s] = sa; }
    }
    __device__ __forceinline__ void mid(f32x4 (&acc)[2][2][4][2], const Unit& u, int wid, int wr, int fr) const {
        const LAS float* T = tab + wid * 256;
#pragma unroll
        for (int ai = 0; ai < 2; ++ai)
#pragma unroll
            for (int m = 0; m < 4; ++m) { const float f = T[64 * ai + 16 * m + fr];
#pragma unroll
                for (int bj = 0; bj < 2; ++bj)
#pragma unroll
                    for (int n = 0; n < 2; ++n) acc[ai][bj][m][n] = acc[ai][bj][m][n] * f; }
    }
    __device__ __forceinline__ void operator()(f32x4 (&acc)[2][2][4][2], const Unit& u, int wid, int wr, int wc, int fr, int fq) const {
        const LAS float* T = tab + wid * 256;
        const int row0 = u.rowbase + u.seg * wr + fr, col0 = u.pn * BM + wc * 32 + 4 * fq;
        const bf16_t* xb = HB + (size_t)row0 * DM + col0;
        u32x2 xv[8][2][2];
#pragma unroll
        for (int g = 0; g < 8; ++g)
#pragma unroll
            for (int bj = 0; bj < 2; ++bj)
#pragma unroll
                for (int n = 0; n < 2; ++n) xv[g][bj][n] = *(const u32x2*)(xb + (size_t)((g >> 2) * 64 + (g & 3) * 16) * DM + bj * HALF + n * 16);
        float q[8];
#pragma unroll
        for (int g = 0; g < 8; ++g) { const int ai = g >> 2, m = g & 3, row = row0 + ai * 64 + m * 16;
            const float sa = T[128 + 64 * ai + 16 * m + fr];
            float qq = 0.f;
#pragma unroll
            for (int bj = 0; bj < 2; ++bj)
#pragma unroll
                for (int n = 0; n < 2; ++n) { const int c = col0 + bj * HALF + n * 16; const u32x2 hw = xv[g][bj][n];
                    f32x4 h = acc[ai][bj][m][n] * sa; h[0] += bflo(hw.x); h[1] += bfhi(hw.x); h[2] += bflo(hw.y); h[3] += bfhi(hw.y);
                    u32x2 w; w.x = pk2(h[0], h[1]); w.y = pk2(h[2], h[3]); *(u32x2*)(HB + (size_t)row * DM + c) = w;
                    qq += (h[0] * h[0] + h[1] * h[1]) + (h[2] * h[2] + h[3] * h[3]); }
            q[g] = qq; }
#pragma unroll
        for (int g = 0; g < 8; ++g) { float s = q[g]; s += __shfl_xor(s, 16); s += __shfl_xor(s, 32);
            if (fq == 0) atomicAdd(ss_h + row0 + (g >> 2) * 64 + (g & 3) * 16, s); }
    }
};
struct EpiOutNorm {
    static constexpr bool PERM = false, MID = false;
    const bf16_t* HB; float* Y; const float* gfin; float* xch; unsigned* pcnt; unsigned* tmo; LAS float* tab;
    __device__ __forceinline__ void pre(const Unit&, int, int, int) const {}
    __device__ __forceinline__ void mid(f32x4 (&)[2][2][4][2], const Unit&, int, int, int) const {}
    __device__ __forceinline__ void operator()(f32x4 (&acc)[2][2][4][2], const Unit& u, int wid, int wr, int wc, int fr, int fq) const {
        const int lane = fq * 16 + fr, tid = wid * 64 + lane;
        const int row0 = u.rowbase + u.seg * wr + fr, col0 = u.pn * BM + wc * 32 + 4 * fq;
        const bf16_t* hb = HB + (size_t)row0 * DM + col0;
        LAS float* P = tab; LAS float* S = tab + 1024;
        u32x2 hv[8][2][2];
#pragma unroll
        for (int g = 0; g < 8; ++g)
#pragma unroll
            for (int bj = 0; bj < 2; ++bj)
#pragma unroll
                for (int n = 0; n < 2; ++n) hv[g][bj][n] = *(const u32x2*)(hb + (size_t)((g >> 2) * 64 + (g & 3) * 16) * DM + bj * HALF + n * 16);
#pragma unroll
        for (int g = 0; g < 8; ++g) { const int ai = g >> 2, m = g & 3;
            float q = 0.f;
#pragma unroll
            for (int bj = 0; bj < 2; ++bj)
#pragma unroll
                for (int n = 0; n < 2; ++n) { const u32x2 hw = hv[g][bj][n]; f32x4 o = acc[ai][bj][m][n];
                    o[0] += bflo(hw.x); o[1] += bfhi(hw.x); o[2] += bflo(hw.y); o[3] += bfhi(hw.y); acc[ai][bj][m][n] = o;
                    q += (o[0] * o[0] + o[1] * o[1]) + (o[2] * o[2] + o[3] * o[3]); }
            q += __shfl_xor(q, 16); q += __shfl_xor(q, 32);
            if (fq == 0) P[(wr * 128 + ai * 64 + m * 16 + fr) * 4 + wc] = q; }
        LDS_BARRIER();
        if (tid < 256) { const f32x4 p4 = *(const LAS f32x4*)(P + tid * 4); const float part = (p4[0] + p4[1]) + (p4[2] + p4[3]);
            unsigned* sl = (unsigned*)(xch + ((size_t)u.pm * 256 + tid) * 8);
            __hip_atomic_store(sl + u.pn, __float_as_uint(part) | 0x80000000u, __ATOMIC_RELAXED, __HIP_MEMORY_SCOPE_AGENT);
            unsigned sp = 0; float ssum = 0.f;
            for (;;) { unsigned v[8]; unsigned all = 0x80000000u;
#pragma unroll
                for (int t = 0; t < 8; ++t) { v[t] = __hip_atomic_load(sl + t, __ATOMIC_RELAXED, __HIP_MEMORY_SCOPE_AGENT); all &= v[t]; }
                ssum = 0.f;
#pragma unroll
                for (int t = 0; t < 8; ++t) ssum += __uint_as_float(v[t] & 0x7fffffffu);
                if (all) break;
                __builtin_amdgcn_s_sleep(2);
                if (++sp > (1u << 18)) { atomicAdd(tmo, 1u); break; } }
            S[tid] = __builtin_amdgcn_rsqf(ssum * (1.0f / DM) + EPS); }
        LDS_BARRIER();
        f32x4 gg[2][2];
#pragma unroll
        for (int bj = 0; bj < 2; ++bj)
#pragma unroll
            for (int n = 0; n < 2; ++n) gg[bj][n] = *(const f32x4*)(gfin + col0 + bj * HALF + n * 16);
        float* yb = Y + (size_t)row0 * DM + col0;
#pragma unroll
        for (int g = 0; g < 8; ++g) { const int ai = g >> 2, m = g & 3; const float rs = S[wr * 128 + ai * 64 + m * 16 + fr];
#pragma unroll
            for (int bj = 0; bj < 2; ++bj)
#pragma unroll
                for (int n = 0; n < 2; ++n) *(f32x4*)(yb + (size_t)(ai * 64 + m * 16) * DM + bj * HALF + n * 16) = acc[ai][bj][m][n] * rs * gg[bj][n]; }
        LDS_WAIT();
    }
};
template <bool SCALED> struct EpiSlab {
    static constexpr bool PERM = false, MID = false;
    float* slab; int kper; const float* ss_rnn; const float* ss_att; LAS float* tab;
    __device__ __forceinline__ void pre(const Unit& u, int wid, int wr, int lane) const {
        if (SCALED) { LAS float* T = tab + wid * 256; const float* ss = (u.k0 < DRNN) ? ss_rnn : ss_att;
#pragma unroll
            for (int i = 0; i < 2; ++i) { const int s = lane + 64 * i, row = u.rowbase + u.seg * wr + s; T[s] = __builtin_amdgcn_rsqf(ss[row] * (1.0f / 1024.0f) + EPS); } }
    }
    __device__ __forceinline__ void mid(f32x4 (&)[2][2][4][2], const Unit&, int, int, int) const {}
    __device__ __forceinline__ void operator()(f32x4 (&acc)[2][2][4][2], const Unit& u, int wid, int wr, int wc, int fr, int fq) const {
        const LAS float* T = tab + wid * 256;
        const int row0 = u.rowbase - MP + u.seg * wr + fr, col0 = u.pn * BM + wc * 32 + 4 * fq;
        float* S = slab + (size_t)(u.k0 / kper) * MS * DM;
#pragma unroll
        for (int ai = 0; ai < 2; ++ai)
#pragma unroll
            for (int m = 0; m < 4; ++m) { const int row = row0 + ai * 64 + m * 16; const float sc = SCALED ? T[64 * ai + 16 * m + fr] : 1.0f;
#pragma unroll
                for (int bj = 0; bj < 2; ++bj)
#pragma unroll
                    for (int n = 0; n < 2; ++n) *(f32x4*)(S + (size_t)row * DM + col0 + bj * HALF + n * 16) = acc[ai][bj][m][n] * sc; }
    }
};
__device__ __forceinline__ float dpp_shr1(float oldv, float src) { return __builtin_bit_cast(float, __builtin_amdgcn_update_dpp(__builtin_bit_cast(int, oldv), __builtin_bit_cast(int, src), 0x111, 0xf, 0xf, false)); }
__device__ __forceinline__ float dpp_shr2(float oldv, float src) { return __builtin_bit_cast(float, __builtin_amdgcn_update_dpp(__builtin_bit_cast(int, oldv), __builtin_bit_cast(int, src), 0x112, 0xf, 0xf, false)); }
__device__ __forceinline__ float dpp_ror1(float src) { return __builtin_bit_cast(float, __builtin_amdgcn_update_dpp(0, __builtin_bit_cast(int, src), 0x121, 0xf, 0xf, false)); }
__device__ __forceinline__ float dpp_ror2(float src) { return __builtin_bit_cast(float, __builtin_amdgcn_update_dpp(0, __builtin_bit_cast(int, src), 0x122, 0xf, 0xf, false)); }
__device__ __forceinline__ void conv_taps_dpp(f32x4& upc, const f32x4 X, const f32x4 Xp, const f32x4 w1, const f32x4 w1m, const f32x4 w0, const f32x4 w0m) {
#define CT_E(e) asm volatile("s_nop 1\n\t" \
        "v_fmac_f32_dpp %0, %1, %3 row_shr:1 row_mask:0xf bank_mask:0xf bound_ctrl:1\n\t" \
        "v_fmac_f32_dpp %0, %2, %4 row_ror:1 row_mask:0xf bank_mask:0xf bound_ctrl:1\n\t" \
        "v_fmac_f32_dpp %0, %1, %5 row_shr:2 row_mask:0xf bank_mask:0xf bound_ctrl:1\n\t" \
        "v_fmac_f32_dpp %0, %2, %6 row_ror:2 row_mask:0xf bank_mask:0xf bound_ctrl:1" \
        : "+v"(u##e) : "v"(x##e), "v"(p##e), "v"(a##e), "v"(b##e), "v"(c##e), "v"(d##e))
    float u0 = upc[0], u1 = upc[1], u2 = upc[2], u3 = upc[3];
    const float x0 = X[0], x1 = X[1], x2 = X[2], x3 = X[3], p0 = Xp[0], p1 = Xp[1], p2 = Xp[2], p3 = Xp[3];
    const float a0 = w1[0], a1 = w1[1], a2 = w1[2], a3 = w1[3], b0 = w1m[0], b1 = w1m[1], b2 = w1m[2], b3 = w1m[3];
    const float c0 = w0[0], c1 = w0[1], c2 = w0[2], c3 = w0[3], d0 = w0m[0], d1 = w0m[1], d2 = w0m[2], d3 = w0m[3];
    CT_E(0); CT_E(1); CT_E(2); CT_E(3);
    upc = (f32x4){u0, u1, u2, u3};
#undef CT_E
}
template <bool SAMPLE> struct EpiAct {
    static constexpr bool PERM = true, MID = false;
    bf16_t* ACT; const float* ss_h; const float* cw; const float* cb; const float* st_ffn; float* o_p_ffn; float* o_s_ffn; unsigned char* wsb; LAS float* tab;
    __device__ __forceinline__ void pre(const Unit& u, int wid, int wr, int lane) const {
        LAS float* T = tab + wid * 384;
        { const int a = lane >> 4, bj = (lane >> 3) & 1, i = lane & 7, wc = wid & 3;
          const float* srcp = (a < 3 ? cw + (size_t)a * NUP : cb) + bj * DFF + u.pn * 128 + wc * 32 + 4 * i;
          __builtin_amdgcn_global_load_lds((const unsigned*)srcp, (LAS unsigned*)T, 16, 0, 0); }
#pragma unroll
        for (int k = 0; k < 2; ++k) { const int s = lane + 64 * k, row = u.rowbase + u.seg * wr + s;
            __builtin_amdgcn_global_load_lds((const unsigned*)(ss_h + (row < 0 ? 0 : row)), (LAS unsigned*)(T + 256 + 64 * k), 4, 0, 0); }
    }
    __device__ __forceinline__ void mid(f32x4 (&)[2][2][4][2], const Unit&, int, int, int) const {}
    __device__ __forceinline__ void operator()(f32x4 (&acc)[2][2][4][2], const Unit& u, int wid, int wr, int wc, int fr, int fq) const {
        constexpr bool sample = SAMPLE;
        const int segrow0 = u.rowbase + u.seg * wr;
        const int jcol = u.pn * 128 + wc * 32 + 8 * fq;
        const int bstart = sample ? 0 : (u.pm / 33) * SEQ;
        const unsigned dump_off = (unsigned)WS_DUMP + (unsigned)(wid * 64 + fq * 16 + fr) * 16u;
        const unsigned act_off = (unsigned)WS_ACT + (unsigned)segrow0 * (unsigned)(DFF * 2) + (unsigned)jcol * 2u;
        const int smax = SEQ - (segrow0 - bstart);
        const LAS float* T = tab + wid * 384;
#pragma unroll
        for (int ai = 0; ai < 2; ++ai)
#pragma unroll
            for (int m = 0; m < 4; ++m) { float rs = __builtin_amdgcn_rsqf(T[256 + 64 * ai + 16 * m + fr] * (1.0f / 2048.0f) + EPS);
                if (!sample && segrow0 + 64 * ai + 16 * m + fr < bstart) rs = 0.f;
#pragma unroll
                for (int bj = 0; bj < 2; ++bj)
#pragma unroll
                    for (int n = 0; n < 2; ++n) acc[ai][bj][m][n] = acc[ai][bj][m][n] * rs; }
        if constexpr (sample) {
            const int tt = fr & 3;
#pragma unroll
            for (int ai = 0; ai < 2; ++ai)
#pragma unroll
                for (int m = 0; m < 4; ++m) { const int row = segrow0 + ai * 64 + m * 16 + fr, sq = (row - MP) >> 2;
                    if (tt >= 2) {
#pragma unroll
                        for (int bj = 0; bj < 2; ++bj)
#pragma unroll
                            for (int n = 0; n < 2; ++n) *(f32x4*)(o_s_ffn + ((size_t)sq * 2 + (tt - 2)) * NUP + bj * DFF + jcol + 4 * n) = acc[ai][bj][m][n]; } }
            asm volatile("" ::: "memory");
#pragma unroll
            for (int n = 0; n < 2; ++n)
#pragma unroll
            for (int pass = 0; pass < 2; ++pass) {
                const int bj = 1 - pass, c = bj * DFF + jcol + 4 * n, ti = (bj * 8 + 2 * fq + n) * 4;
                const f32x4 w0 = *(const LAS f32x4*)(T + ti), w1 = *(const LAS f32x4*)(T + 64 + ti), w2 = *(const LAS f32x4*)(T + 128 + ti), bb = *(const LAS f32x4*)(T + 192 + ti);
                const f32x4 zero4 = {0.f, 0.f, 0.f, 0.f};
                const f32x4 w1z = (tt == 0) ? w1 : zero4, w1n = (tt == 0) ? zero4 : w1, w0z = (tt < 2) ? w0 : zero4, w0n = (tt < 2) ? zero4 : w0;
#pragma unroll
                for (int ai = 0; ai < 2; ++ai) {
                    f32x4 sA4[4], sB4[4];
#pragma unroll
                    for (int m = 0; m < 4; ++m) { const int sq = (segrow0 + ai * 64 + m * 16 + fr - MP) >> 2;
                        const float* sp = st_ffn + ((size_t)sq * 2 + 1) * NUP + c;
                        sB4[m] = *(const f32x4*)(sp);
                        sA4[m] = *(const f32x4*)(sp - (tt == 0 ? NUP : 0)); }
#pragma unroll
                    for (int m = 0; m < 4; ++m) {
                    const int row = segrow0 + ai * 64 + m * 16 + fr;
                    const f32x4 X = acc[ai][bj][m][n];
                    f32x4 upc = bb + w2 * X + w1z * sB4[m] + w0z * sA4[m];
#pragma unroll
                    for (int e = 0; e < 4; ++e) { float ue = upc[e]; const float xe = X[e], a1 = w1n[e], a0 = w0n[e];
                        asm volatile("s_nop 1\n\t"
                                     "v_fmac_f32_dpp %0, %1, %2 row_shr:1 row_mask:0xf bank_mask:0xf bound_ctrl:1\n\t"
                                     "v_fmac_f32_dpp %0, %1, %3 row_shr:2 row_mask:0xf bank_mask:0xf bound_ctrl:1"
                                     : "+v"(ue) : "v"(xe), "v"(a1), "v"(a0));
                        upc[e] = ue; }
                    if (pass == 0) acc[ai][1][m][n] = upc;
                    else {
                        upc = gelu_mul4(upc, acc[ai][1][m][n]);
                        u32x2 w; w.x = pk2(upc[0], upc[1]); w.y = pk2(upc[2], upc[3]); *(u32x2*)(ACT + (size_t)row * DFF + jcol + 4 * n) = w;
                    }
                    asm volatile("" ::: "memory");
                    __builtin_amdgcn_sched_barrier(0);
                    }
                }
            }
        } else {
            if (u.pm % 33 == 32) {
#pragma unroll
                for (int ai = 0; ai < 2; ++ai)
#pragma unroll
                    for (int m = 0; m < 4; ++m) { const int s = 64 * ai + 16 * m + fr, tl = segrow0 + s - bstart;
                        if (s >= 2 && (tl == SEQ - 2 || tl == SEQ - 1)) {
#pragma unroll
                            for (int bj = 0; bj < 2; ++bj)
#pragma unroll
                                for (int n = 0; n < 2; ++n) *(f32x4*)(o_p_ffn + ((size_t)(u.pm / 33) * 2 + (tl - (SEQ - 2))) * NUP + bj * DFF + jcol + 4 * n) = acc[ai][bj][m][n]; } }
                asm volatile("" ::: "memory");
            }
#pragma unroll
            for (int n = 0; n < 2; ++n)
#pragma unroll
            for (int pass = 0; pass < 2; ++pass) {
                const int bj = 1 - pass, c = bj * DFF + jcol + 4 * n, ti = (bj * 8 + 2 * fq + n) * 4;
                const f32x4 w0 = *(const LAS f32x4*)(T + ti), w1 = *(const LAS f32x4*)(T + 64 + ti), w2 = *(const LAS f32x4*)(T + 128 + ti), bb = *(const LAS f32x4*)(T + 192 + ti);
                const f32x4 w1m = (fr == 0) ? w1 : (f32x4){0.f, 0.f, 0.f, 0.f}, w0m = (fr < 2) ? w0 : (f32x4){0.f, 0.f, 0.f, 0.f};
#pragma unroll
                for (int g = 7; g >= 0; --g) { const int ai = g >> 2, m = g & 3, gp = (g > 0 ? g - 1 : 0);
                    const int s = 64 * ai + 16 * m + fr;
                    const f32x4 X = acc[ai][bj][m][n];
                    const f32x4 Xp = acc[gp >> 2][bj][gp & 3][n];
                    f32x4 upc = bb + w2 * X;
                    conv_taps_dpp(upc, X, Xp, w1, w1m, w0, w0m);
                    if (pass == 0) acc[ai][1][m][n] = upc;
                    else {
                        upc = gelu_mul4(upc, acc[ai][1][m][n]);
                        const unsigned px = pk2(upc[0], upc[1]), py = pk2(upc[2], upc[3]);
                        if (n == 0) { acc[ai][1][m][0][0] = __uint_as_float(px); acc[ai][1][m][0][1] = __uint_as_float(py); }
                        else {
                            const bool ok = (g > 0 || fr >= 2) && (s < smax);
                            const unsigned off = ok ? (act_off + (unsigned)s * (unsigned)(DFF * 2)) : dump_off;
                            *(u32x4*)(wsb + off) = (u32x4){__float_as_uint(acc[ai][1][m][0][0]), __float_as_uint(acc[ai][1][m][0][1]), px, py};
                        }
                    }
                    __builtin_amdgcn_sched_barrier(0);
                }
                asm volatile("" ::: "memory");
            }
        }
    }
};
}


#define XB_TMO      128
#define XB_XCNT(j)  (256  + 64 * (j))
#define XB_XSUB(j)  (1280 + 64 * (j))
#define XB_XGEN(j)  (2304 + 64 * (j))
#define XB_TOP      3328
#define XB_TOPGEN   3392
#define XCD_BAR_WORDS 3456
#define XB_SPIN_CAP (1u << 22)
__device__ __forceinline__ unsigned xb_ld(unsigned* p)              { return __hip_atomic_load(p, __ATOMIC_RELAXED, __HIP_MEMORY_SCOPE_AGENT); }
__device__ __forceinline__ unsigned xb_add(unsigned* p, unsigned v) { return __hip_atomic_fetch_add(p, v, __ATOMIC_RELAXED, __HIP_MEMORY_SCOPE_AGENT); }
__device__ __forceinline__ unsigned xb_xcc_id() { return (unsigned)__builtin_amdgcn_s_getreg((3 << 11) | 20) & 0xFu; }
#define XB_SPIN(cond, bar) do { unsigned _sp = 0; while (cond) { __builtin_amdgcn_s_sleep(1); \
    if ((++_sp & 255u) == 0u) { if (xb_ld(&(bar)[XB_TMO])) break; if (_sp > XB_SPIN_CAP) { atomicAdd(&(bar)[XB_TMO], 1u); break; } } } } while (0)
struct XcdBarrier { unsigned* bar; unsigned x; volatile LAS unsigned* st; };
__device__ __forceinline__ XcdBarrier xcd_barrier_post(unsigned* bar, volatile LAS unsigned* st) {
    XcdBarrier b; b.bar = bar; b.x = xb_xcc_id(); b.st = st;
    if (threadIdx.x == 0) (void)xb_add(&bar[XB_XCNT(b.x)], 1u);
    return b;
}
__device__ __forceinline__ void xcd_barrier_complete(unsigned* bar, unsigned x, unsigned& nloc, unsigned& nx) {
    const unsigned G = gridDim.x * gridDim.y * gridDim.z;
    unsigned sum, cnt, mine, sp = 0u;
    for (;;) {
        sum = 0u; cnt = 0u; mine = 0u;
#pragma unroll
        for (unsigned j = 0; j < 16; ++j) { const unsigned c = xb_ld(&bar[XB_XCNT(j)]); sum += c; cnt += (c > 0u) ? 1u : 0u; mine = (j == x) ? c : mine; }
        if (sum == G) break;
        __builtin_amdgcn_s_sleep(1);
        if ((++sp & 255u) == 0u) { if (xb_ld(&bar[XB_TMO])) break; if (sp > XB_SPIN_CAP) { atomicAdd(&bar[XB_TMO], 1u); break; } }
    }
    nloc = mine > 0u ? mine : 1u; nx = cnt > 0u ? cnt : 1u;
}
__device__ __forceinline__ void xcd_barrier(const XcdBarrier& b) {
    asm volatile("s_waitcnt vmcnt(0)" ::: "memory");
    __syncthreads();
    if (threadIdx.x == 0) {
        unsigned* bar = b.bar;
        __builtin_amdgcn_s_waitcnt(0);
        unsigned nloc = b.st[0], nx = b.st[1];
        if (nloc == 0u) { xcd_barrier_complete(bar, b.x, nloc, nx); b.st[0] = nloc; b.st[1] = nx; }
        const unsigned old = xb_add(&bar[XB_XSUB(b.x)], 1u);
        const unsigned gen = old / nloc;
        if (old + 1u == (gen + 1u) * nloc) {
            __builtin_amdgcn_fence(__ATOMIC_RELEASE, "agent");
            asm volatile("s_waitcnt vmcnt(0)" ::: "memory");
            const unsigned og = xb_add(&bar[XB_TOP], 1u);
            const unsigned tg = og / nx;
            if (og + 1u == (tg + 1u) * nx) xb_add(&bar[XB_TOPGEN], 1u);
            else XB_SPIN(xb_ld(&bar[XB_TOPGEN]) == tg, bar);
            __builtin_amdgcn_fence(__ATOMIC_ACQUIRE, "agent");
            xb_add(&bar[XB_XGEN(b.x)], 1u);
            asm volatile("s_waitcnt vmcnt(0)" ::: "memory");
        } else {
            XB_SPIN(xb_ld(&bar[XB_XGEN(b.x)]) == gen, bar);
            __builtin_amdgcn_fence(__ATOMIC_ACQUIRE, "agent");
            asm volatile("s_waitcnt vmcnt(0)" ::: "memory");
        }
    }
    __syncthreads();
}


__device__ __forceinline__ void split_arrive(unsigned* cnt) {
    asm volatile("s_waitcnt vmcnt(0)" ::: "memory");
    __syncthreads();
    if (threadIdx.x == 0) { __builtin_amdgcn_fence(__ATOMIC_RELEASE, "agent"); asm volatile("s_waitcnt vmcnt(0)" ::: "memory"); (void)xb_add(cnt, 1u); }
}
__device__ __forceinline__ void split_wait(unsigned* cnt, unsigned* tmo, unsigned target = 0u) {
    if (threadIdx.x == 0) { const unsigned G = target ? target : gridDim.x; unsigned sp = 0;
        while (xb_ld(cnt) < G) { __builtin_amdgcn_s_sleep(1); if ((++sp & 255u) == 0u) { if (xb_ld(tmo)) break; if (sp > XB_SPIN_CAP) { atomicAdd(tmo, 1u); break; } } }
        __builtin_amdgcn_fence(__ATOMIC_ACQUIRE, "agent"); asm volatile("s_waitcnt vmcnt(0)" ::: "memory"); }
    __syncthreads();
}

struct Args {
    const float* in[27]; float* out; unsigned char* ws; int ph_lo, ph_hi;
};
struct Ctx {
    LAS unsigned char* lds; int tid, lane, wave, bid, G;
    const float* const* in; float* out; unsigned char* ws;
};

template <bool UPMAP>
__device__ __forceinline__ void p0_transpose_item(const float* W, int K, int N, bf16_t* WT, const float* gk, LAS unsigned char* scr, int item, int lane) {
    const int nblk = N / 64, kb = item / nblk, nb = item % nblk, k0 = 64 * kb, n0 = 64 * nb;
    const int n4 = lane & 15, kg = lane >> 4;
    f32x4 v[4][4];
#pragma unroll
    for (int i = 0; i < 4; ++i)
#pragma unroll
        for (int j = 0; j < 4; ++j) v[i][j] = *(const f32x4*)(W + (size_t)(k0 + 16 * i + 4 * kg + j) * N + n0 + 4 * n4);
    if (gk) {
#pragma unroll
        for (int i = 0; i < 4; ++i) { const f32x4 g4 = *(const f32x4*)(gk + k0 + 16 * i + 4 * kg);
#pragma unroll
            for (int j = 0; j < 4; ++j) v[i][j] = v[i][j] * g4[j]; } }
#pragma unroll
    for (int i = 0; i < 4; ++i) {
        const int q = 4 * i + kg;
#pragma unroll
        for (int e = 0; e < 4; ++e) { const int n = 4 * n4 + e; u32x2 w; w.x = pk2(v[i][0][e], v[i][1][e]); w.y = pk2(v[i][2][e], v[i][3][e]);
            *(LAS u32x2*)(scr + n * 128 + ((q ^ n4) * 8)) = w; }
    }
    LDS_WAIT(); asm volatile("" ::: "memory");
    int d0 = n0;
    if (UPMAP) d0 = (n0 < DFF) ? (256 * (n0 / 128) + (n0 % 128)) : (256 * ((n0 - DFF) / 128) + 128 + ((n0 - DFF) % 128));
    const int c16 = lane & 7;
#pragma unroll
    for (int p = 0; p < 8; ++p) { const int n = (lane >> 3) + 8 * p, s = (n >> 2) & 15, pos = (2 * c16) ^ s;
        u32x4 r = *(const LAS u32x4*)(scr + n * 128 + (pos & ~1) * 8);
        if (s & 1) r = (u32x4){r.z, r.w, r.x, r.y};
        *(u32x4*)(WT + (size_t)(d0 + n) * K + k0 + 8 * c16) = r; }
    LDS_WAIT(); asm volatile("" ::: "memory");
}
__device__ __forceinline__ void convert_weights(const Ctx& F, int which, int part, int nparts) {
    LAS unsigned char* scr = F.lds + F.wave * 16384;
    const int gw = part * NWAVES + F.wave, NGW = nparts * NWAVES;
    bf16_t* WIN = (bf16_t*)(F.ws + WS_WIN); bf16_t* WOUT = (bf16_t*)(F.ws + WS_WOUT); bf16_t* WUP = (bf16_t*)(F.ws + WS_WUP); bf16_t* WDOWN = (bf16_t*)(F.ws + WS_WDOWN);
    constexpr int I_IN = (DM / 64) * (NPROJ / 64), I_OUT = (DM / 64) * (DM / 64), I_UP = (DM / 64) * (NUP / 64), I_DOWN = (DFF / 64) * (DM / 64);
    if (which & 1) for (int r = gw; r < I_IN; r += NGW) p0_transpose_item<false>(F.in[8], DM, NPROJ, WIN, F.in[7], scr, r, F.lane);
    if (which & 2) for (int r = gw; r < I_OUT; r += NGW) {
        const int nblk = DM / 64, kb = r / nblk; const float* g = (kb < 16) ? F.in[18] : (F.in[19] - 1024);
        p0_transpose_item<false>(F.in[20], DM, DM, WOUT, g, scr, r, F.lane); }
    if (which & 4) for (int r = gw; r < I_UP; r += NGW) p0_transpose_item<true>(F.in[22], DM, NUP, WUP, F.in[21], scr, r, F.lane);
    constexpr int I_DOWN_A = (I_DOWN * 5) / 8;
    if (which & 8) for (int r = gw; r < I_DOWN_A; r += NGW) p0_transpose_item<false>(F.in[25], DFF, DM, WDOWN, nullptr, scr, r, F.lane);
    if (which & 16) for (int r = I_DOWN_A + gw; r < I_DOWN; r += NGW) p0_transpose_item<false>(F.in[25], DFF, DM, WDOWN, nullptr, scr, r, F.lane);
}
__device__ __forceinline__ void p0_prologue(const Ctx& F) {
    const int gw = F.bid * NWAVES + F.wave, NGW = F.G * NWAVES;
    convert_weights(F, 1, F.bid, F.G);
    { unsigned* xz = (unsigned*)(F.ws + WS_XCH); const int gt = F.bid * NTHREADS + F.tid, NGT = F.G * NTHREADS;
      for (int i = gt; i < 64 * 256 * 8; i += NGT) __hip_atomic_store(xz + i, 0u, __ATOMIC_RELAXED, __HIP_MEMORY_SCOPE_AGENT); }
    { bf16_t* WG = (bf16_t*)(F.ws + WS_WG); const int gt = F.bid * NTHREADS + F.tid, NGT = F.G * NTHREADS;
      for (int idx = gt; idx < 16 * 128 * 64; idx += NGT) { const int blk = idx >> 13, n = (idx >> 6) & 127, k = idx & 63;
          const float v = (n < 64) ? F.in[11][(blk * 64 + k) * 64 + n] : F.in[13][(blk * 64 + k) * 64 + (n - 64)];
          WG[idx] = (bf16_t)(pk2(v, 0.f) & 0xffffu); } }
    if (gw == 0) { u32x4* z = (u32x4*)(F.ws + WS_XN - 2 * DM * 2);
#pragma unroll
        for (int j = 0; j < 8; ++j) z[F.lane + 64 * j] = (u32x4){0u, 0u, 0u, 0u}; }
    { bf16_t* XN = (bf16_t*)(F.ws + WS_XN); float* RSX = (float*)(F.ws + CT_RSTD_X);
      for (int m = gw; m < MT; m += NGW) {
          const float* xr = (m < MP) ? F.in[0] + (size_t)m * DM : F.in[1] + (size_t)(m - MP) * DM;
          f32x4 v[8]; float s = 0.f;
#pragma unroll
          for (int j = 0; j < 8; ++j) { v[j] = *(const f32x4*)(xr + 4 * (F.lane + 64 * j)); s += (v[j][0] * v[j][0] + v[j][1] * v[j][1]) + (v[j][2] * v[j][2] + v[j][3] * v[j][3]); }
#pragma unroll
          for (int j = 0; j < 8; ++j) { const f32x4 o = v[j];
              u32x2 w; w.x = pk2(o[0], o[1]); w.y = pk2(o[2], o[3]); *(u32x2*)(XN + (size_t)m * DM + 4 * (F.lane + 64 * j)) = w; }
          const float rstd = __builtin_amdgcn_rsqf(wave_sum(s) * (1.0f / DM) + EPS);
          if (F.lane == 0) RSX[m] = rstd; } }
}

__device__ __forceinline__ f32x4 ld_bf4(const bf16_t* p) { const u32x2 w = *(const u32x2*)p; return (f32x4){bflo(w.x), bfhi(w.x), bflo(w.y), bfhi(w.y)}; }
__device__ __forceinline__ void p2_copies(const Ctx& F, int part, int nparts) {
    const bf16_t* PROJ = (const bf16_t*)(F.ws + WS_PROJ);
    const int gt = part * NTHREADS + F.tid, NGT = nparts * NTHREADS;
    for (int base = gt; base < 2 * 128 * 128 * 64; base += 8 * NGT) {
        f32x4 v[8];
#pragma unroll
        for (int t = 0; t < 8; ++t) { const int idx = base + t * NGT; v[t] = (f32x4){0.f, 0.f, 0.f, 0.f};
            if (idx < 2 * 128 * 128 * 64) { const int kv = idx / (128 * 128 * 64), r = idx % (128 * 128 * 64), s = r / (128 * 64), w = (r / 64) % 128, c4 = r % 64;
                if (w < 124) v[t] = *(const f32x4*)(F.in[4 + kv] + ((size_t)(s * 128 + w + 4)) * 256 + 4 * c4);
                else v[t] = ld_bf4(PROJ + (size_t)(MP + 4 * s + (w - 124)) * NPROJ + (kv ? COL_V : COL_K) + 4 * c4); } }
#pragma unroll
        for (int t = 0; t < 8; ++t) { const int idx = base + t * NGT;
            if (idx < 2 * 128 * 128 * 64) { const int kv = idx / (128 * 128 * 64), r = idx % (128 * 128 * 64); *(f32x4*)(F.out + (kv ? O_S_WV : O_S_WK) + (size_t)r * 4) = v[t]; } }
    }
    for (int idx = gt; idx < 2 * 2 * 128 * 64; idx += NGT) {
        const int kv = idx / (2 * 128 * 64), r = idx % (2 * 128 * 64), b = r / (128 * 64), w = (r / 64) % 128, c4 = r % 64;
        *(f32x4*)(F.out + (kv ? O_P_WV : O_P_WK) + (size_t)r * 4) = ld_bf4(PROJ + (size_t)(b * SEQ + SEQ - 128 + w) * NPROJ + (kv ? COL_V : COL_K) + 4 * c4);
    }
    for (int idx = gt; idx < 2 * 3 * 256; idx += NGT) { const int b = idx / (3 * 256), j = (idx / 256) % 3, c4 = idx % 256;
        *(f32x4*)(F.out + O_P_RCONV + (size_t)idx * 4) = ld_bf4(PROJ + (size_t)(b * SEQ + SEQ - 3 + j) * NPROJ + COL_XR + 4 * c4); }
    for (int idx = gt; idx < 128 * 3 * 256; idx += NGT) { const int s = idx / (3 * 256), j = (idx / 256) % 3, c4 = idx % 256;
        *(f32x4*)(F.out + O_S_RCONV + (size_t)idx * 4) = ld_bf4(PROJ + (size_t)(MP + 4 * s + 1 + j) * NPROJ + COL_XR + 4 * c4); }
}

constexpr int R_WGL = 0, R_WAVE = 18432, R_WSTRIDE = 5120, R_XCBW = 2688, R_WT = 59392, R_PART = 67584, R_HIN = 75776, R_END = 77824;
template <int MODE>
__device__ __forceinline__ void rnn_phase(const Ctx& F, int n_units) {
    const bf16_t* PROJ = (const bf16_t*)(F.ws + WS_PROJ);
    const int tid = F.tid, lane = F.lane, w = F.wave, l15 = lane & 15, q = lane >> 4;
    LAS bf16_t* WGL = (LAS bf16_t*)(F.lds + R_WGL);
    LAS bf16_t* XBw = (LAS bf16_t*)(F.lds + R_WAVE + w * R_WSTRIDE); LAS bf16_t* XCBw = (LAS bf16_t*)(F.lds + R_WAVE + w * R_WSTRIDE + R_XCBW);
    LAS float* HINw = (LAS float*)(F.lds + R_HIN) + w * 64;
    int cur_blk = -1, par = 0;
    LDS_BARRIER();
    u32x4 n_vx[3], n_du[4]; u32x2 n_gv[4]; f32x2 n_sv[8];
#define RNN_DECODE(unit_, b_, c_, blk_, row0_) do { if (MODE == 2) { blk_ = (unit_) & 15; c_ = (unit_) >> 4; b_ = 0; row0_ = MP + 128 * c_; } \
        else { blk_ = (unit_) & 15; c_ = ((unit_) >> 4) & 63; b_ = (unit_) >> 10; row0_ = b_ * SEQ + 128 * c_; } } while (0)
#define RNN_LOADS(unit_) do { int b_, c_, blk_, row0_; RNN_DECODE(unit_, b_, c_, blk_, row0_); const int tk0_ = 16 * w + 4 * q, gch0_ = blk_ * 64 + 4 * l15; \
        if (MODE != 0) { const bf16_t* gp0 = PROJ + (size_t)(row0_ + tk0_) * NPROJ + COL_GR + gch0_; \
            _Pragma("unroll") for (int r = 0; r < 4; ++r) n_gv[r] = *(const u32x2*)(gp0 + (size_t)r * NPROJ); } \
        if (MODE == 1) { const unsigned* DUp = (const unsigned*)(F.ws + WS_DU) + (size_t)(row0_ + tk0_) * DRNN + gch0_; \
            _Pragma("unroll") for (int r = 0; r < 4; ++r) n_du[r] = *(const u32x4*)(DUp + (size_t)r * DRNN); \
            const float* SUMM = (const float*)(F.ws + WS_SUMM); \
            _Pragma("unroll") for (int kk = 0; kk < 8; ++kk) { const int k = 8 * w + kk, kc = (k < c_) ? k : 0; n_sv[kk] = *(const f32x2*)(SUMM + ((size_t)(b_ * 64 + kc) * 1024 + blk_ * 64 + lane) * 2); } } \
        else { _Pragma("unroll") for (int t = 0; t < 3; ++t) { const int id = lane + 64 * t, i = id >> 3, ch = id & 7; n_vx[t] = (u32x4){0u, 0u, 0u, 0u}; \
                const int cr = 16 * w - 3 + i; const bool ok = (id < 19 * 8) && ((MODE == 2) ? (cr >= 0) : (c_ > 0 || cr >= 0)); \
                if (ok) n_vx[t] = *(const u32x4*)(PROJ + (size_t)(row0_ + cr) * NPROJ + COL_XR + blk_ * 64 + ch * 8); } } } while (0)
    f32x4 cw0 = {0.f, 0.f, 0.f, 0.f}, cw1 = cw0, cw2 = cw0, cw3 = cw0, cbv = cw0, ba4 = cw0, bx4 = cw0, lam4 = cw0;
    if (F.bid < n_units) RNN_LOADS(F.bid);
    for (int unit = F.bid; unit < n_units; unit += F.G, par ^= 1) {
        int b = 0, c = 0, blk, row0;
        RNN_DECODE(unit, b, c, blk, row0);
        LAS float* WT = (LAS float*)(F.lds + R_WT) + par * 1024; LAS float* PART = (LAS float*)(F.lds + R_PART) + par * 1024;
        if (MODE != 1 && blk != cur_blk) {
            if (cur_blk >= 0) LDS_BARRIER();
            const bf16_t* WG = (const bf16_t*)(F.ws + WS_WG) + (size_t)blk * 8192;
#pragma unroll
            for (int t = 0; t < 2; ++t) { const int id = tid + NTHREADS * t, np = id >> 3, ch = id & 7, j = np >> 4, l = np & 15, n = 64 * (j >> 2) + 4 * l + (j & 3);
                *(LAS u32x4*)(WGL + np * 72 + ch * 8) = *(const u32x4*)(WG + n * 64 + ch * 8); }
            { const int g0 = blk * 64 + 4 * l15;
              cw0 = *(const f32x4*)(F.in[9] + g0); cw1 = *(const f32x4*)(F.in[9] + 1024 + g0); cw2 = *(const f32x4*)(F.in[9] + 2048 + g0); cw3 = *(const f32x4*)(F.in[9] + 3072 + g0);
              cbv = *(const f32x4*)(F.in[10] + g0); ba4 = *(const f32x4*)(F.in[12] + g0); bx4 = *(const f32x4*)(F.in[14] + g0); lam4 = *(const f32x4*)(F.in[15] + g0); }
            LDS_BARRIER(); cur_blk = blk;
        }
        const int tk0 = 16 * w + 4 * q, gch0 = blk * 64 + 4 * l15;
        unsigned* DU = (unsigned*)(F.ws + WS_DU) + (size_t)(row0 + tk0) * DRNN + gch0;
        float av[4][4], uv[4][4], P4[4], H4[4];
        u32x4 vx[3], du4[4]; u32x2 gvv[4]; f32x2 sv[8];
#pragma unroll
        for (int r = 0; r < 4; ++r) { gvv[r] = n_gv[r]; du4[r] = n_du[r]; }
#pragma unroll
        for (int t = 0; t < 3; ++t) vx[t] = n_vx[t];
#pragma unroll
        for (int kk = 0; kk < 8; ++kk) sv[kk] = n_sv[kk];
        if (unit + F.G < n_units) RNN_LOADS(unit + F.G);
        if (MODE == 1) {
            float P = 1.f, H = 0.f;
#pragma unroll
            for (int kk = 0; kk < 8; ++kk) { const int k = 8 * w + kk; if (k < c) { H = H * sv[kk].x + sv[kk].y; P = P * sv[kk].x; } }
            PART[(w * 64 + lane) * 2] = P; PART[(w * 64 + lane) * 2 + 1] = H;
#pragma unroll
            for (int jj = 0; jj < 4; ++jj) { float Pj = 1.f, Hj = 0.f;
#pragma unroll
                for (int r = 0; r < 4; ++r) { const float a = 1.0f - bflo(du4[r][jj]), u = bfhi(du4[r][jj]); av[jj][r] = a; uv[jj][r] = u; Hj = Hj * a + u; Pj = Pj * a; }
                P4[jj] = Pj; H4[jj] = Hj; }
        } else {
#pragma unroll
        for (int t = 0; t < 3; ++t) { const int id = lane + 64 * t, i = id >> 3, ch = id & 7;
            if (id < 19 * 8) { *(LAS u32x2*)(XBw + i * 68 + ch * 8) = (u32x2){vx[t].x, vx[t].y}; *(LAS u32x2*)(XBw + i * 68 + ch * 8 + 4) = (u32x2){vx[t].z, vx[t].w}; } }
        LDS_WAIT();
        f32x4 xin[7];
#pragma unroll
        for (int j = 0; j < 7; ++j) { const u32x2 p = *(const LAS u32x2*)(XBw + (4 * q + j) * 68 + 4 * l15); xin[j] = (f32x4){bflo(p.x), bfhi(p.x), bflo(p.y), bfhi(p.y)}; }
        if (MODE == 2) { const int sq = (row0 - MP) / 4 + 4 * w + q;
#pragma unroll
            for (int j = 0; j < 3; ++j) xin[j] = *(const f32x4*)(F.in[2] + ((size_t)sq * 3 + j) * 1024 + gch0); }
        f32x4 xc[4];
#pragma unroll
        for (int r = 0; r < 4; ++r) { xc[r] = cbv + cw0 * xin[r] + cw1 * xin[r + 1] + cw2 * xin[r + 2] + cw3 * xin[r + 3];
            *(LAS u32x2*)(XCBw + (4 * q + r) * 72 + 4 * l15) = (u32x2){pk2(xc[r][0], xc[r][1]), pk2(xc[r][2], xc[r][3])}; }
        LDS_WAIT();
        f32x4 ga[8];
#pragma unroll
        for (int j = 0; j < 8; ++j) ga[j] = (f32x4){0.f, 0.f, 0.f, 0.f};
#pragma unroll
        for (int ks = 0; ks < 2; ++ks) { const bf16x8 af = *(const LAS bf16x8*)(XCBw + l15 * 72 + 32 * ks + 8 * q);
#pragma unroll
            for (int j = 0; j < 8; ++j) { const bf16x8 bfr = *(const LAS bf16x8*)(WGL + (16 * j + l15) * 72 + 32 * ks + 8 * q);
                ga[j] = __builtin_amdgcn_mfma_f32_16x16x32_bf16(af, bfr, ga[j], 0, 0, 0); } }
        u32x4 pw4[4];
#pragma unroll
        for (int jj = 0; jj < 4; ++jj) { const float ba = ba4[jj], bx = bx4[jj], lam = lam4[jj];
            const float c8 = (8.0f * 1.4426950408889634f) * ((lam < -15.f) ? -lam : __logf(1.0f + __expf(-lam)));
            const f32x4 ta = (ga[jj] + ba) * (-1.4426950408889634f), tx = (ga[4 + jj] + bx) * (-1.4426950408889634f);
            f32x4 ea, ex;
#pragma unroll
            for (int r = 0; r < 4; ++r) { ea[r] = __builtin_amdgcn_exp2f(ta[r]); ex[r] = __builtin_amdgcn_exp2f(tx[r]); }
            ea = ea + 1.0f; ex = ex + 1.0f;
            const f32x4 den = ea * ex; f32x4 rc;
#pragma unroll
            for (int r = 0; r < 4; ++r) rc[r] = __builtin_amdgcn_rcpf(den[r]);
            const f32x4 rr = ex * rc, ii = ea * rc, la = rr * (-c8);
            f32x4 a4;
#pragma unroll
            for (int r = 0; r < 4; ++r) a4[r] = __builtin_amdgcn_exp2f(la[r]);
            f32x4 om = 1.0f - a4 * a4, sq;
#pragma unroll
            for (int r = 0; r < 4; ++r) sq[r] = __builtin_amdgcn_sqrtf(fmaxf(om[r], 0.f));
            const f32x4 xcj = {xc[0][jj], xc[1][jj], xc[2][jj], xc[3][jj]};
            f32x4 u4 = sq * (ii * xcj);
            if (MODE == 0) {
#pragma unroll
                for (int r = 0; r < 4; ++r) { const unsigned pw = pk2(1.0f - a4[r], u4[r]); pw4[r][jj] = pw; a4[r] = 1.0f - bflo(pw); u4[r] = bfhi(pw); } }
            float P = 1.f, H = 0.f;
#pragma unroll
            for (int r = 0; r < 4; ++r) { av[jj][r] = a4[r]; uv[jj][r] = u4[r]; H = H * a4[r] + u4[r]; P = P * a4[r]; }
            P4[jj] = P; H4[jj] = H; }
        if (MODE == 0) {
#pragma unroll
            for (int r = 0; r < 4; ++r) *(u32x4*)(DU + (size_t)r * DRNN) = pw4[r]; }
        }
        LAS bf16_t* YBw = XBw;
        if (MODE == 2) {
            const int sq = (row0 - MP) / 4 + 4 * w + q;
            const f32x4 h0 = *(const f32x4*)(F.in[3] + (size_t)sq * 1024 + gch0);
            float ssq[4] = {0.f, 0.f, 0.f, 0.f}; f32x4 hfin; float yv[4][4];
#pragma unroll
            for (int jj = 0; jj < 4; ++jj) { float h = h0[jj];
#pragma unroll
                for (int r = 0; r < 4; ++r) { h = av[jj][r] * h + uv[jj][r];
                    const float g = (jj & 1) ? bfhi(jj < 2 ? gvv[r].x : gvv[r].y) : bflo(jj < 2 ? gvv[r].x : gvv[r].y);
                    const float y = gelu_tanh(g) * h; yv[r][jj] = y; ssq[r] += y * y; }
                hfin[jj] = h; }
            *(f32x4*)(F.out + O_S_RH + (size_t)sq * 1024 + gch0) = hfin;
#pragma unroll
            for (int r = 0; r < 4; ++r) { *(LAS u32x2*)(YBw + (4 * q + r) * 68 + 4 * l15) = (u32x2){pk2(yv[r][0], yv[r][1]), pk2(yv[r][2], yv[r][3])};
                float s = ssq[r]; s += __shfl_xor(s, 1); s += __shfl_xor(s, 2); s += __shfl_xor(s, 4); s += __shfl_xor(s, 8);
                if (l15 == 0) atomicAdd((float*)(F.ws + CT_SS_RNN) + row0 + tk0 + r, s); }
        } else {
            float E_P[4], E_H[4], T_P[4], T_H[4];
#pragma unroll
            for (int jj = 0; jj < 4; ++jj) { float eP = 1.f, eH = 0.f, tP = 1.f, tH = 0.f;
#pragma unroll
                for (int g = 0; g < 4; ++g) { const float pg = __shfl(P4[jj], l15 + 16 * g), hg = __shfl(H4[jj], l15 + 16 * g);
                    if (g < q) { eH = eH * pg + hg; eP = eP * pg; }
                    tH = tH * pg + hg; tP = tP * pg; }
                E_P[jj] = eP; E_H[jj] = eH; T_P[jj] = tP; T_H[jj] = tH; }
            if (q == 0) { LAS float* wt = WT + (w * 64 + 4 * l15) * 2;
                *(LAS f32x4*)wt = (f32x4){T_P[0], T_H[0], T_P[1], T_H[1]}; *(LAS f32x4*)(wt + 4) = (f32x4){T_P[2], T_H[2], T_P[3], T_H[3]}; }
            LDS_BARRIER();
            if (MODE == 0) {
                if (tid < 64) { float P = 1.f, H = 0.f;
#pragma unroll
                    for (int p = 0; p < 8; ++p) { const float pp = WT[(p * 64 + tid) * 2], hh = WT[(p * 64 + tid) * 2 + 1]; H = H * pp + hh; P = P * pp; }
                    float* SUMM = (float*)(F.ws + WS_SUMM); *(f32x2*)(SUMM + ((size_t)(b * 64 + c) * 1024 + blk * 64 + tid) * 2) = (f32x2){P, H}; }
            } else {
                { float h = 0.f; float pp[8], ph[8], wp[7], wh[7];
#pragma unroll
                  for (int p = 0; p < 8; ++p) { pp[p] = PART[(p * 64 + lane) * 2]; ph[p] = PART[(p * 64 + lane) * 2 + 1]; }
#pragma unroll
                  for (int p = 0; p < 7; ++p) { wp[p] = WT[(p * 64 + lane) * 2]; wh[p] = WT[(p * 64 + lane) * 2 + 1]; }
#pragma unroll
                  for (int p = 0; p < 8; ++p) h = h * pp[p] + ph[p];
#pragma unroll
                  for (int p = 0; p < 7; ++p) if (p < w) h = h * wp[p] + wh[p];
                  HINw[lane] = h; }
                LDS_WAIT();
                const f32x4 hin = *(const LAS f32x4*)(HINw + 4 * l15);
                float ssq[4] = {0.f, 0.f, 0.f, 0.f}; f32x4 hfin; float yv[4][4];
#pragma unroll
                for (int jj = 0; jj < 4; ++jj) { float h = hin[jj] * E_P[jj] + E_H[jj];
#pragma unroll
                    for (int r = 0; r < 4; ++r) { h = av[jj][r] * h + uv[jj][r];
                        const float g = (jj & 1) ? bfhi(jj < 2 ? gvv[r].x : gvv[r].y) : bflo(jj < 2 ? gvv[r].x : gvv[r].y);
                        const float y = gelu_tanh(g) * h; yv[r][jj] = y; ssq[r] += y * y; }
                    hfin[jj] = h; }
                if (c == 63 && w == 7 && q == 3) *(f32x4*)(F.out + O_P_RH + (size_t)b * 1024 + gch0) = hfin;
#pragma unroll
                for (int r = 0; r < 4; ++r) { *(LAS u32x2*)(YBw + (4 * q + r) * 68 + 4 * l15) = (u32x2){pk2(yv[r][0], yv[r][1]), pk2(yv[r][2], yv[r][3])};
                    float s = ssq[r]; s += __shfl_xor(s, 1); s += __shfl_xor(s, 2); s += __shfl_xor(s, 4); s += __shfl_xor(s, 8);
                    if (l15 == 0) atomicAdd((float*)(F.ws + CT_SS_RNN) + row0 + tk0 + r, s); }
            }
        }
        if (MODE != 0) {
            LDS_WAIT();
#pragma unroll
            for (int t = 0; t < 2; ++t) { const int id = lane + 64 * t, i = id >> 3, ch = id & 7;
                const u32x2 a = *(const LAS u32x2*)(YBw + i * 68 + ch * 8), b2 = *(const LAS u32x2*)(YBw + i * 68 + ch * 8 + 4);
                *(u32x4*)((bf16_t*)(F.ws + WS_MERGED) + (size_t)(row0 + 16 * w + i) * DM + blk * 64 + ch * 8) = (u32x4){a.x, a.y, b2.x, b2.y}; }
            LDS_WAIT();
        }
    }
}

#undef RNN_LOADS
#undef RNN_DECODE
__device__ __forceinline__ int t5_bucket(int n) {
    if (n < 16) return n;
    int l = 16 + (int)(__logf((float)n * (1.0f / 16.0f)) * (16.0f / 2.0794415416798357f));
    return l < 31 ? l : 31;
}
constexpr int A_KL = 0, A_VT = 36864, A_BIAS = 70656, A_END = 81152;
__device__ __forceinline__ void attn_prompt_unit(const Ctx& F, int unit, bool first) {
    const bf16_t* PROJ = (const bf16_t*)(F.ws + WS_PROJ);
    const int tid = F.tid, lane = F.lane, w = F.wave, l15 = lane & 15, q = lane >> 4;
    const int kvh = unit & 3, qb = (unit >> 2) & 63, b = unit >> 8;
    LAS bf16_t* KL = (LAS bf16_t*)(F.lds + A_KL); LAS bf16_t* VT = (LAS bf16_t*)(F.lds + A_VT); LAS float* BIAS = (LAS float*)(F.lds + A_BIAS);
    LAS float* TB = (LAS float*)(F.lds + A_END);
    LDS_BARRIER();
    float tbv = 0.f;
    if (first && tid < 128) tbv = F.in[17][(tid >> 2) * 16 + 4 * kvh + (tid & 3)] * 1.4426950408889634f;
    const int kb0 = qb * 128 - 128;
#pragma unroll
    for (int i = 0; i < 4; ++i) { const int id = tid + NTHREADS * i, r = id >> 3, ch = id & 7; const int t = kb0 + r;
        u32x4 v = {0u, 0u, 0u, 0u};
        if (t >= 0) v = *(const u32x4*)(PROJ + (size_t)(b * SEQ + t) * NPROJ + COL_K + kvh * 64 + ch * 8);
        *(LAS u32x4*)(KL + r * 72 + ch * 8) = v; }
#pragma unroll
    for (int i = 0; i < 4; ++i) { const int id = tid + NTHREADS * i, key = id & 255, ch = id >> 8; const int t = kb0 + key;
        u32x4 v = {0u, 0u, 0u, 0u};
        if (t >= 0) v = *(const u32x4*)(PROJ + (size_t)(b * SEQ + t) * NPROJ + COL_V + kvh * 64 + ch * 8);
        LAS bf16_t* d = VT + (ch * 8) * 264 + key;
        d[0 * 264] = (bf16_t)(v.x & 0xffffu); d[1 * 264] = (bf16_t)(v.x >> 16); d[2 * 264] = (bf16_t)(v.y & 0xffffu); d[3 * 264] = (bf16_t)(v.y >> 16);
        d[4 * 264] = (bf16_t)(v.z & 0xffffu); d[5 * 264] = (bf16_t)(v.z >> 16); d[6 * 264] = (bf16_t)(v.w & 0xffffu); d[7 * 264] = (bf16_t)(v.w >> 16); }
    if (first) {
        if (tid < 128) TB[tid] = tbv;
        LDS_BARRIER();
        for (int id = tid; id < 4 * 4 * 164; id += NTHREADS) { const int cp = id / 656, g = (id / 164) & 3, k = id % 164, d = 144 + cp - k;
            BIAS[id] = (d >= 0 && d < 128) ? TB[t5_bucket(d) * 4 + g] : -1e30f; } }
    LDS_BARRIER();
    const int i_q = 16 * w + l15;
    const int qrow = b * SEQ + qb * 128 + i_q;
    bf16x8 qfa[4][2];
#pragma unroll
    for (int g = 0; g < 4; ++g) { qfa[g][0] = *(const bf16x8*)(PROJ + (size_t)qrow * NPROJ + COL_Q + (4 * kvh + g) * 64 + 8 * q); qfa[g][1] = *(const bf16x8*)(PROJ + (size_t)qrow * NPROJ + COL_Q + (4 * kvh + g) * 64 + 32 + 8 * q); }
#pragma unroll
    for (int g = 0; g < 4; ++g) {
        const int head = 4 * kvh + g;
        const bf16x8 qf0 = qfa[g][0], qf1 = qfa[g][1];
        f32x4 sc[10];
#pragma unroll
        for (int jj = 0; jj < 9; ++jj) { const int j = w + jj; sc[jj] = (f32x4){0.f, 0.f, 0.f, 0.f};
            const bf16x8 k0 = *(const LAS bf16x8*)(KL + (16 * j + l15) * 72 + 8 * q), k1 = *(const LAS bf16x8*)(KL + (16 * j + l15) * 72 + 32 + 8 * q);
            sc[jj] = __builtin_amdgcn_mfma_f32_16x16x32_bf16(k0, qf0, sc[jj], 0, 0, 0); sc[jj] = __builtin_amdgcn_mfma_f32_16x16x32_bf16(k1, qf1, sc[jj], 0, 0, 0);
            if (jj & 1) asm volatile("" ::: "memory"); }
        sc[9] = (f32x4){0.f, 0.f, 0.f, 0.f};
        const float sink = F.in[16][head] * 1.4426950408889634f;
        const LAS float* bt = BIAS + ((l15 & 3) * 4 + g) * 164 + (144 + (l15 & 3) - (128 + i_q - 16 * w - 4 * q));
        float mx = sink;
#pragma unroll
        for (int jj = 0; jj < 9; ++jj) { f32x4 s4 = sc[jj] * (0.125f * 1.4426950408889634f) + *(const LAS f32x4*)(bt + 16 * jj);
            if (qb == 0) {
#pragma unroll
                for (int r = 0; r < 4; ++r) { const int jk = 16 * (w + jj) + 4 * q + r; s4[r] = (jk >= 128) ? s4[r] : -1e30f; } }
            sc[jj] = s4; mx = fmaxf(fmaxf(mx, fmaxf(s4[0], s4[1])), fmaxf(s4[2], s4[3])); }
        mx = fmaxf(mx, __shfl_xor(mx, 16)); mx = fmaxf(mx, __shfl_xor(mx, 32));
        f32x4 l4 = {0.f, 0.f, 0.f, 0.f};
#pragma unroll
        for (int jj = 0; jj < 9; ++jj) { const f32x4 d4 = sc[jj] - mx; f32x4 p4;
            p4[0] = __builtin_amdgcn_exp2f(d4[0]); p4[1] = __builtin_amdgcn_exp2f(d4[1]); p4[2] = __builtin_amdgcn_exp2f(d4[2]); p4[3] = __builtin_amdgcn_exp2f(d4[3]);
            sc[jj] = p4; l4 = l4 + p4; }
        float l = (l4[0] + l4[1]) + (l4[2] + l4[3]);
        l += __shfl_xor(l, 16); l += __shfl_xor(l, 32);
        const float inv = __builtin_amdgcn_rcpf(l + __builtin_amdgcn_exp2f(sink - mx));
        f32x4 o[4];
#pragma unroll
        for (int dt = 0; dt < 4; ++dt) o[dt] = (f32x4){0.f, 0.f, 0.f, 0.f};
#pragma unroll
        for (int pp = 0; pp < 5; ++pp) {
            u32x4 pw; pw.x = pk2(sc[2 * pp][0], sc[2 * pp][1]); pw.y = pk2(sc[2 * pp][2], sc[2 * pp][3]); pw.z = pk2(sc[2 * pp + 1][0], sc[2 * pp + 1][1]); pw.w = pk2(sc[2 * pp + 1][2], sc[2 * pp + 1][3]);
            const bf16x8 pf = __builtin_bit_cast(bf16x8, pw);
            const int j0 = w + 2 * pp; int j1 = j0 + 1; if (j1 > 15) j1 = 15;
#pragma unroll
            for (int dt = 0; dt < 4; ++dt) { const LAS bf16_t* vr = VT + (16 * dt + l15) * 264;
                const u32x2 a0 = *(const LAS u32x2*)(vr + 16 * j0 + 4 * q), a1 = *(const LAS u32x2*)(vr + 16 * j1 + 4 * q);
                const bf16x8 vf = __builtin_bit_cast(bf16x8, (u32x4){a0.x, a0.y, a1.x, a1.y});
                o[dt] = __builtin_amdgcn_mfma_f32_16x16x32_bf16(vf, pf, o[dt], 0, 0, 0); }
            asm volatile("" ::: "memory"); }
        float ssq = 0.f;
        bf16_t* yo = (bf16_t*)(F.ws + WS_MERGED) + (size_t)qrow * DM + DRNN + head * 64 + 4 * q;
#pragma unroll
        for (int dt = 0; dt < 4; ++dt) { const f32x4 v = o[dt] * inv; ssq += (v[0] * v[0] + v[1] * v[1]) + (v[2] * v[2] + v[3] * v[3]);
            u32x2 wv; wv.x = pk2(v[0], v[1]); wv.y = pk2(v[2], v[3]); *(u32x2*)(yo + 16 * dt) = wv; }
        ssq += __shfl_xor(ssq, 16); ssq += __shfl_xor(ssq, 32);
        if (q == 0) atomicAdd((float*)(F.ws + CT_SS_ATT) + qrow, ssq);
    }
}
constexpr int AS_PW = 0, AS_BIAS = 24576, AS_RED = 45056, AS_TB = 77824;
__device__ __forceinline__ void attn_sample_unit(const Ctx& F, int unit) {
    const bf16_t* PROJ = (const bf16_t*)(F.ws + WS_PROJ);
    const int lane = F.lane, w = F.wave, l15 = lane & 15, q = lane >> 4;
    const int task = w >> 2, part = w & 3;
    const int wu = unit * 2 + task, s = wu >> 2, kvh = wu & 3;
    LAS float* PW = (LAS float*)(F.lds + AS_PW + w * 3072);
    LAS float* RED = (LAS float*)(F.lds + AS_RED + task * 16384);
    LDS_BARRIER();
    const int g = l15 >> 2, qi = l15 & 3, head = 4 * kvh + g;
    const size_t qrow = (size_t)(MP + 4 * s + qi);
    const bf16x8 qf0 = *(const bf16x8*)(PROJ + qrow * NPROJ + COL_Q + head * 64 + 8 * q);
    const bf16x8 qf1 = *(const bf16x8*)(PROJ + qrow * NPROJ + COL_Q + head * 64 + 32 + 8 * q);
    const float tb0 = F.in[17][(lane >> 2) * 16 + 4 * kvh + (lane & 3)], tb1 = F.in[17][(16 + (lane >> 2)) * 16 + 4 * kvh + (lane & 3)];
    f32x4 sc[9];
#pragma unroll
    for (int j = 0; j < 8; ++j) { const int kk = 16 * j + l15; sc[j] = (f32x4){0.f, 0.f, 0.f, 0.f};
        const float* kp = F.in[4] + ((size_t)(s * 128 + kk) * 4 + kvh) * 64 + 8 * q;
        const f32x4 a = *(const f32x4*)kp, bq = *(const f32x4*)(kp + 4), cq = *(const f32x4*)(kp + 32), dq = *(const f32x4*)(kp + 36);
        const bf16x8 k0 = __builtin_bit_cast(bf16x8, (u32x4){pk2(a[0], a[1]), pk2(a[2], a[3]), pk2(bq[0], bq[1]), pk2(bq[2], bq[3])});
        const bf16x8 k1 = __builtin_bit_cast(bf16x8, (u32x4){pk2(cq[0], cq[1]), pk2(cq[2], cq[3]), pk2(dq[0], dq[1]), pk2(dq[2], dq[3])});
        sc[j] = __builtin_amdgcn_mfma_f32_16x16x32_bf16(k0, qf0, sc[j], 0, 0, 0); sc[j] = __builtin_amdgcn_mfma_f32_16x16x32_bf16(k1, qf1, sc[j], 0, 0, 0);
        if (j % 3 == 2) asm volatile("" ::: "memory"); }
    {
        const bf16_t* kp = PROJ + (size_t)(MP + 4 * s + (l15 & 3)) * NPROJ + COL_K + kvh * 64 + 8 * q;
        u32x4 a = *(const u32x4*)kp, b2 = *(const u32x4*)(kp + 32);
        if (l15 >= 4) { a = (u32x4){0u, 0u, 0u, 0u}; b2 = a; }
        sc[8] = (f32x4){0.f, 0.f, 0.f, 0.f};
        sc[8] = __builtin_amdgcn_mfma_f32_16x16x32_bf16(__builtin_bit_cast(bf16x8, a), qf0, sc[8], 0, 0, 0); sc[8] = __builtin_amdgcn_mfma_f32_16x16x32_bf16(__builtin_bit_cast(bf16x8, b2), qf1, sc[8], 0, 0, 0); }
    const float sink = F.in[16][head] * 1.4426950408889634f;
    LAS float* BT = (LAS float*)(F.lds + AS_BIAS + w * 2560); LAS float* TB = (LAS float*)(F.lds + AS_TB + w * 512);
    TB[lane] = tb0 * 1.4426950408889634f; TB[64 + lane] = tb1 * 1.4426950408889634f;
    LDS_WAIT(); asm volatile("" ::: "memory");
    for (int id = lane; id < 640; id += 64) { const int gg = id / 160, d = id % 160 - 16; BT[id] = (d >= 0 && d < 128) ? TB[t5_bucket(d) * 4 + gg] : -1e30f; }
    LDS_WAIT(); asm volatile("" ::: "memory");
    float mx = sink;
#pragma unroll
    for (int j = 0; j < 9; ++j)
#pragma unroll
        for (int r = 0; r < 4; ++r) { const int key = 16 * j + 4 * q + r, dist = 128 + qi - key;
            const float sv = sc[j][r] * (0.125f * 1.4426950408889634f) + BT[g * 160 + dist + 16]; sc[j][r] = sv; mx = fmaxf(mx, sv); }
    mx = fmaxf(mx, __shfl_xor(mx, 16)); mx = fmaxf(mx, __shfl_xor(mx, 32));
    float l = 0.f;
#pragma unroll
    for (int j = 0; j < 9; ++j)
#pragma unroll
        for (int r = 0; r < 4; ++r) { const float p = __builtin_amdgcn_exp2f(sc[j][r] - mx); sc[j][r] = p; l += p; }
    l += __shfl_xor(l, 16); l += __shfl_xor(l, 32);
    const float inv = __builtin_amdgcn_rcpf(l + __builtin_amdgcn_exp2f(sink - mx));
#pragma unroll
    for (int j = 0; j < 8; ++j)
        if ((j >> 1) == part) {
#pragma unroll
            for (int r = 0; r < 4; ++r) PW[(16 * (j & 1) + 4 * q + r) * 16 + l15] = sc[j][r] * inv; }
    if (part == 3) {
#pragma unroll
        for (int r = 0; r < 4; ++r) PW[(32 + 4 * q + r) * 16 + l15] = sc[8][r] * inv; }
    LDS_WAIT(); asm volatile("" ::: "memory");
    float o[16];
#pragma unroll
    for (int i = 0; i < 16; ++i) o[i] = 0.f;
#pragma unroll 1
    for (int kb = 0; kb < 2; ++kb) { float vv[16];
#pragma unroll
      for (int j = 0; j < 16; ++j) vv[j] = F.in[5][((size_t)(s * 128 + 32 * part + 16 * kb + j) * 4 + kvh) * 64 + lane];
#pragma unroll
      for (int j = 0; j < 16; ++j) { const float v = vv[j]; const int key = 16 * kb + j;
          const f32x4 p0 = *(const LAS f32x4*)(PW + key * 16), p1 = *(const LAS f32x4*)(PW + key * 16 + 4), p2 = *(const LAS f32x4*)(PW + key * 16 + 8), p3 = *(const LAS f32x4*)(PW + key * 16 + 12);
#pragma unroll
          for (int e = 0; e < 4; ++e) { o[e] += p0[e] * v; o[4 + e] += p1[e] * v; o[8 + e] += p2[e] * v; o[12 + e] += p3[e] * v; } } }
    if (part == 3) { float vn[4];
#pragma unroll
      for (int j = 0; j < 4; ++j) vn[j] = bf2f(PROJ[(size_t)(MP + 4 * s + j) * NPROJ + COL_V + kvh * 64 + lane]);
#pragma unroll
      for (int j = 0; j < 4; ++j) { const int key = 32 + j; const float v = vn[j];
          const f32x4 p0 = *(const LAS f32x4*)(PW + key * 16), p1 = *(const LAS f32x4*)(PW + key * 16 + 4), p2 = *(const LAS f32x4*)(PW + key * 16 + 8), p3 = *(const LAS f32x4*)(PW + key * 16 + 12);
#pragma unroll
          for (int e = 0; e < 4; ++e) { o[e] += p0[e] * v; o[4 + e] += p1[e] * v; o[8 + e] += p2[e] * v; o[12 + e] += p3[e] * v; } } }
#pragma unroll
    for (int i = 0; i < 16; ++i) RED[(part * 16 + i) * 64 + lane] = o[i];
    LDS_BARRIER();
#pragma unroll
    for (int qq = 0; qq < 4; ++qq) { const int i = part * 4 + qq;
        const float t = (RED[(0 * 16 + i) * 64 + lane] + RED[(1 * 16 + i) * 64 + lane]) + (RED[(2 * 16 + i) * 64 + lane] + RED[(3 * 16 + i) * 64 + lane]);
        ((bf16_t*)(F.ws + WS_MERGED))[(size_t)(MP + 4 * s + qq) * DM + DRNN + (4 * kvh + part) * 64 + lane] = (bf16_t)(pk2(t, 0.f) & 0xffffu);
        const float t2 = wave_sum(t * t); if (lane == 0) atomicAdd((float*)(F.ws + CT_SS_ATT) + MP + 4 * s + qq, t2); }
}

__device__ __forceinline__ void p7_final(const Ctx& F) {
    const float* g = F.in[26]; const float* slab = (const float*)(F.ws + WS_SLAB); const bf16_t* HB = (const bf16_t*)(F.ws + WS_XN); LAS float* red = (LAS float*)F.lds;
    for (int m0 = 2 * F.bid; m0 < MS; m0 += 2 * F.G) { const int m = m0 + (F.wave >> 2), qd = F.wave & 3; float* yr = F.out + (size_t)(MP + m) * DM;
        f32x4 v[2];
#pragma unroll
        for (int j = 0; j < 2; ++j) v[j] = ld_bf4(HB + (size_t)(MP + m) * DM + 512 * qd + 4 * (F.lane + 64 * j));
#pragma unroll
        for (int sp0 = 0; sp0 < 16; sp0 += 8) { f32x4 t[8][2];
#pragma unroll
            for (int sp = 0; sp < 8; ++sp)
#pragma unroll
                for (int j = 0; j < 2; ++j) t[sp][j] = *(const f32x4*)(slab + ((size_t)(sp0 + sp) * MS + m) * DM + 512 * qd + 4 * (F.lane + 64 * j));
#pragma unroll
            for (int j = 0; j < 2; ++j) v[j] = v[j] + (((t[0][j] + t[1][j]) + (t[2][j] + t[3][j])) + ((t[4][j] + t[5][j]) + (t[6][j] + t[7][j]))); }
        float s = 0.f;
#pragma unroll
        for (int j = 0; j < 2; ++j) s += (v[j][0] * v[j][0] + v[j][1] * v[j][1]) + (v[j][2] * v[j][2] + v[j][3] * v[j][3]);
        s = wave_sum(s);
        LDS_BARRIER();
        if (F.lane == 0) red[F.wave] = s;
        LDS_BARRIER();
        const int w0 = F.wave & 4; const float rstd = __builtin_amdgcn_rsqf(((red[w0] + red[w0 + 1]) + (red[w0 + 2] + red[w0 + 3])) * (1.0f / DM) + EPS);
#pragma unroll
        for (int j = 0; j < 2; ++j) { const int cidx = 512 * qd + 4 * (F.lane + 64 * j); const f32x4 gg = *(const f32x4*)(g + cidx); *(f32x4*)(yr + cidx) = v[j] * rstd * gg; } }
}

__global__ void __launch_bounds__(NTHREADS, 2) hymba_fwd(Args args) {
    extern __shared__ __attribute__((aligned(16))) unsigned char lds_raw[];
    Ctx F; F.lds = (LAS unsigned char*)lds_raw; F.tid = threadIdx.x; F.lane = F.tid & 63; F.wave = __builtin_amdgcn_readfirstlane(F.tid >> 6);
    F.bid = blockIdx.x; F.G = gridDim.x; F.in = args.in; F.out = args.out; F.ws = args.ws;
    const int lo = args.ph_lo, hi = args.ph_hi;
    XcdBarrier bar; bar.bar = (unsigned*)(F.ws + CT_BAR); bar.x = 0; bar.st = (volatile LAS unsigned*)(F.lds + LDS_MISC);
    if (MK_N_LAUNCHES == 1) { if (F.tid < 64) ((LAS unsigned*)(F.lds + LDS_MISC))[F.tid] = 0u; __syncthreads(); bar = xcd_barrier_post((unsigned*)(F.ws + CT_BAR), (volatile LAS unsigned*)(F.lds + LDS_MISC)); }
#define IN(k) (lo <= (k) && (k) < hi)
#define RELAUNDER() do { int t_ = threadIdx.x; asm volatile("" : "+v"(t_)); F.tid = t_; F.lane = t_ & 63; } while (0)
#define GRIDBAR() do { if (MK_N_LAUNCHES == 1) xcd_barrier(bar); } while (0)
#define SEAM(k) do { if (IN(k) && IN((k) + 1)) { GRIDBAR(); } } while (0)
    bf16_t* XN = (bf16_t*)(F.ws + WS_XN); bf16_t* PROJ = (bf16_t*)(F.ws + WS_PROJ); bf16_t* MERGED = (bf16_t*)(F.ws + WS_MERGED); bf16_t* ACT = (bf16_t*)(F.ws + WS_ACT);
    float* SS_RNN = (float*)(F.ws + CT_SS_RNN); float* SS_ATT = (float*)(F.ws + CT_SS_ATT); float* SS_H = (float*)(F.ws + CT_SS_H);

    if (IN(0)) { RELAUNDER(); p0_prologue(F); }
    SEAM(0);
    if (IN(1)) { RELAUNDER(); gm::Order<0> S; S.init(MT / 256, NPROJ / 256, F.G, F.bid); gm::EpiProj E{PROJ, NPROJ, (const float*)(F.ws + CT_RSTD_X), (LAS float*)(F.lds + gm::STAGE_BYTES)};
        gm::gemm_phase(F.lds, XN, (const bf16_t*)(F.ws + WS_WIN), DM, DM / 64, S, E);
        { const int nfull = (MT / 256) * (NPROJ / 256) - 3 * F.G;
          if (F.G == 256 && F.bid >= nfull) convert_weights(F, 2 | 4, F.bid - nfull, F.G - nfull);
          else if (F.G != 256) convert_weights(F, 2 | 4, F.bid, F.G); } }
    SEAM(1);
    if (IN(2)) { RELAUNDER();
        rnn_phase<0>(F, 2048);
        if (MK_N_LAUNCHES == 1) split_arrive((unsigned*)(F.ws + CT_BAR2));
        for (int u = F.bid; u < 512; u += F.G) attn_prompt_unit(F, u, u == F.bid || (F.G & 3) != 0);
        for (int u = F.bid; u < 256; u += F.G) attn_sample_unit(F, u);
        if (F.G == 256) { if (F.bid < 64) rnn_phase<2>(F, 64); else p2_copies(F, F.bid - 64, F.G - 64); }
        else p2_copies(F, F.bid, F.G);
    }
    if (MK_N_LAUNCHES != 1) SEAM(2);
    if (IN(3)) { RELAUNDER();
        if (MK_N_LAUNCHES == 1) split_wait((unsigned*)(F.ws + CT_BAR2), (unsigned*)(F.ws + CT_BAR) + XB_TMO);
        rnn_phase<1>(F, 2048);
        if (F.G != 256) rnn_phase<2>(F, 64);
    }
    SEAM(3);
    if (IN(4)) { RELAUNDER();
        if (F.G != 256) convert_weights(F, 8, F.bid, F.G);
        __syncthreads();
        { gm::SplitOrder S; S.init(8, 256, F.G, (F.G == 256) ? ((F.bid & 1) ? F.G : (F.bid >> 1)) : F.bid); gm::EpiSlab<true> E{(float*)(F.ws + WS_SLAB), 256, SS_RNN, SS_ATT, (LAS float*)(F.lds + gm::STAGE_BYTES)};
          gm::gemm_phase(F.lds, MERGED, (const bf16_t*)(F.ws + WS_WOUT), DM, 4, S, E); }
        if (MK_N_LAUNCHES == 1 && F.G == 256 && (F.bid & 1) == 0) split_arrive((unsigned*)(F.ws + CT_BAR3));
        { gm::Order<0> S; S.init(MP / 256, DM / 256, F.G, F.bid); gm::EpiH E{F.in[0], F.in[1], XN, SS_RNN, SS_ATT, SS_H, (LAS float*)(F.lds + gm::STAGE_BYTES)};
          gm::gemm_phase(F.lds, MERGED, (const bf16_t*)(F.ws + WS_WOUT), DM, DM / 64, S, E); }
        const bool fast4 = (MK_N_LAUNCHES == 1 && F.G == 256);
        int cpart = F.bid, cnparts = F.G; bool do_combine = true;
        if (fast4) { do_combine = (F.bid & 1) != 0; cpart = F.bid >> 1; cnparts = 128;
            if (do_combine) split_wait((unsigned*)(F.ws + CT_BAR3), (unsigned*)(F.ws + CT_BAR) + XB_TMO, 128u); }
        else GRIDBAR();
        if (do_combine) { const float* slab = (const float*)(F.ws + WS_SLAB); LAS float* red = (LAS float*)F.lds;
          for (int m0 = 2 * cpart; m0 < MS; m0 += 2 * cnparts) { const int m = m0 + (F.wave >> 2), qd = F.wave & 3;
            f32x4 v[2], t[8][2];
#pragma unroll
            for (int j = 0; j < 2; ++j) { const int cidx = 512 * qd + 4 * (F.lane + 64 * j); v[j] = *(const f32x4*)(F.in[1] + (size_t)m * DM + cidx);
#pragma unroll
                for (int sp = 0; sp < 8; ++sp) t[sp][j] = *(const f32x4*)(slab + ((size_t)sp * MS + m) * DM + cidx); }
            float s = 0.f;
#pragma unroll
            for (int j = 0; j < 2; ++j) { const int cidx = 512 * qd + 4 * (F.lane + 64 * j);
                v[j] = v[j] + (((t[0][j] + t[1][j]) + (t[2][j] + t[3][j])) + ((t[4][j] + t[5][j]) + (t[6][j] + t[7][j])));
                u32x2 w; w.x = pk2(v[j][0], v[j][1]); w.y = pk2(v[j][2], v[j][3]); *(u32x2*)(XN + (size_t)(MP + m) * DM + cidx) = w;
                s += (v[j][0] * v[j][0] + v[j][1] * v[j][1]) + (v[j][2] * v[j][2] + v[j][3] * v[j][3]); }
            s = wave_sum(s);
            LDS_BARRIER();
            if (F.lane == 0) red[F.wave] = s;
            LDS_BARRIER();
            if (qd == 0 && F.lane == 0) SS_H[MP + m] = (red[F.wave] + red[F.wave + 1]) + (red[F.wave + 2] + red[F.wave + 3]); } }
        if (fast4) GRIDBAR();
        else if (MK_N_LAUNCHES == 1) split_arrive((unsigned*)(F.ws + CT_BAR3));
    }
    if (MK_N_LAUNCHES != 1) SEAM(4);
    if (IN(5)) { RELAUNDER();
        {
            { gm::Order<1> S; S.init(66, NUP / 256, F.G, F.bid); gm::EpiAct<false> E{ACT, SS_H, F.in[23], F.in[24], F.in[6], F.out + O_P_FFN, F.out + O_S_FFN, F.ws, (LAS float*)(F.lds + gm::STAGE_BYTES)};
              gm::gemm_phase(F.lds, XN, (const bf16_t*)(F.ws + WS_WUP), DM, DM / 64, S, E); }
            if (MK_N_LAUNCHES == 1 && F.G != 256) split_wait((unsigned*)(F.ws + CT_BAR3), (unsigned*)(F.ws + CT_BAR) + XB_TMO);
            { gm::Order<2> S; S.init(2, NUP / 256, F.G, (F.bid + F.G - 96 % F.G) % F.G); gm::EpiAct<true> E{ACT, SS_H, F.in[23], F.in[24], F.in[6], F.out + O_P_FFN, F.out + O_S_FFN, F.ws, (LAS float*)(F.lds + gm::STAGE_BYTES)};
              gm::gemm_phase(F.lds, XN, (const bf16_t*)(F.ws + WS_WUP), DM, DM / 64, S, E); }
        }
        if (F.G == 256 && F.bid >= 192) convert_weights(F, 8 | 16, F.bid - 192, 64);
        else if (F.G != 256) convert_weights(F, 16, F.bid, F.G);
    }
    SEAM(5);
    if (IN(6)) { RELAUNDER();
        { gm::Order<3> S; S.init(MP / 256, DM / 256, F.G, F.bid);
          gm::EpiOutNorm E{XN, F.out, F.in[26], (float*)(F.ws + WS_XCH), (unsigned*)(F.ws + CT_PCNT), (unsigned*)(F.ws + CT_BAR) + XB_TMO, (LAS float*)(F.lds + gm::STAGE_BYTES)};
          gm::gemm_phase(F.lds, ACT, (const bf16_t*)(F.ws + WS_WDOWN), DFF, DFF / 64, S, E); }
        { gm::SplitOrder S; S.init(16, 384, F.G, F.bid); gm::EpiSlab<false> E{(float*)(F.ws + WS_SLAB), 384, nullptr, nullptr, (LAS float*)(F.lds + gm::STAGE_BYTES)};
          gm::gemm_phase(F.lds, ACT, (const bf16_t*)(F.ws + WS_WDOWN), DFF, 6, S, E); }
    }
    SEAM(6);
    if (IN(7)) { RELAUNDER(); p7_final(F); }
#undef IN
#undef SEAM
}

extern "C" void kernel_launch(void* const* d_in, const int* in_sizes, int n_in, void* d_out, int out_size, void* d_ws, size_t ws_size, hipStream_t stream) {
    static int grid = 0;
    if (grid == 0) {
        if (n_in != 27 || out_size != (int)O_END || ws_size < WS_END) { fprintf(stderr, "kernel_launch: unexpected shapes (n_in %d out %d ws %zu)\n", n_in, out_size, ws_size); grid = -1; return; }
        int dev = 0, cus = 0, per_cu = 0;
        hipGetDevice(&dev); hipDeviceGetAttribute(&cus, hipDeviceAttributeMultiprocessorCount, dev);
        hipFuncSetAttribute((const void*)hymba_fwd, hipFuncAttributeMaxDynamicSharedMemorySize, LDS_BYTES);
        hipOccupancyMaxActiveBlocksPerMultiprocessor(&per_cu, (const void*)hymba_fwd, NTHREADS, LDS_BYTES);
        if (per_cu < 1) { fprintf(stderr, "kernel_launch: occupancy query says %d blocks per CU\n", per_cu); per_cu = 1; }
        (void)hipGetLastError();
        grid = cus;
    }
    if (grid < 0) return;
    hipMemsetAsync((char*)d_ws + WS_CTL, 0, CTL_BYTES, stream);
    Args a{};
    for (int i = 0; i < 27; ++i) a.in[i] = (const float*)d_in[i];
    a.out = (float*)d_out; a.ws = (unsigned char*)d_ws;
    if (MK_N_LAUNCHES == 1) {
        a.ph_lo = 0; a.ph_hi = 8;
        void* kargs[] = {&a};
        hipError_t e = hipLaunchCooperativeKernel((const void*)hymba_fwd, dim3(grid), dim3(NTHREADS), kargs, LDS_BYTES, stream);
        if (e != hipSuccess) fprintf(stderr, "kernel_launch: cooperative launch failed: %s (grid %d)\n", hipGetErrorString(e), grid);
    } else {
        for (int p = 0; p < 8; ++p) { a.ph_lo = p; a.ph_hi = p + 1; hipLaunchKernelGGL(hymba_fwd, dim3(grid), dim3(NTHREADS), LDS_BYTES, stream, a); }
    }
}
```
